# Optimizing an MI355X kernel written in HIP

```python
import functools
import jax, jax.numpy as jnp
from jax import lax
import numpy as np

D_MODEL = 1024
BATCH = 4
SEQ = 8192
DEPTH = 1
DEC_BATCH = 8
DEC_SEQ = 16
PAST_LEN = 4096

CHUNK = 64
BAND_CHUNKS = 8
WINDOW = BAND_CHUNKS * CHUNK
ATT_HEADS = 16
ATT_HEAD_DIM = 64
ATT_WIDTH = ATT_HEADS * ATT_HEAD_DIM
MAX_REL = 256
SSD_WIDTH = 2 * D_MODEL
SSD_HEAD_DIM = 64
SSD_HEADS = SSD_WIDTH // SSD_HEAD_DIM
SSD_GROUPS = 4
SSD_STATE = 128
CONV_WIDTH = 4
CONV_CH = SSD_WIDTH + 2 * SSD_GROUPS * SSD_STATE
N_BRANCH = 2
EPS = 1e-6
IN_SIZES = (ATT_WIDTH, ATT_WIDTH, ATT_WIDTH, ATT_WIDTH, SSD_WIDTH, CONV_CH, SSD_HEADS, N_BRANCH * D_MODEL)
IN_DIM = sum(IN_SIZES)
IN_SPLITS = tuple(int(v) for v in np.cumsum(IN_SIZES)[:-1])

kernel_name = "hybrid_chunkband_ssd_streaming_step"


def rms_norm(x, g):
    xf = x.astype(jnp.float32)
    y = xf * lax.rsqrt(jnp.mean(xf * xf, axis=-1, keepdims=True) + EPS)
    return (y * g.astype(jnp.float32)).astype(x.dtype)


def rel_bias_for(q_pos, k_pos, rel_bias):
    idx = jnp.clip(q_pos[:, None] - k_pos[None, :], -MAX_REL, MAX_REL) + MAX_REL
    return rel_bias[:, idx]


def attend(q, k, v, bias, mask):
    s = jnp.einsum('bqhd,bkhd->bhqk', q, k).astype(jnp.float32) * (ATT_HEAD_DIM ** -0.5) + bias[None].astype(jnp.float32)
    s = jnp.where(mask, s, -1e30)
    p = jax.nn.softmax(s, axis=-1).astype(v.dtype)
    return jnp.einsum('bhqk,bkhd->bqhd', p, v)


def prompt_attention(q, k, v, rel_bias):
    b, s = q.shape[:2]
    nc = s // CHUNK
    band = WINDOW + CHUNK
    kp = jnp.pad(k, ((0, 0), (WINDOW, 0), (0, 0), (0, 0)))
    vp = jnp.pad(v, ((0, 0), (WINDOW, 0), (0, 0), (0, 0)))
    k_loc = jnp.arange(band)
    bias = rel_bias_for(jnp.arange(CHUNK) + WINDOW, k_loc, rel_bias)
    qc = jnp.moveaxis(q.reshape(b, nc, CHUNK, ATT_HEADS, ATT_HEAD_DIM), 1, 0)

    def one_chunk(args):
        i, qi = args
        start = i * CHUNK
        kb = lax.dynamic_slice_in_dim(kp, start, band, axis=1)
        vb = lax.dynamic_slice_in_dim(vp, start, band, axis=1)
        mask = (start - WINDOW + k_loc >= 0)[None, None, None, :]
        return attend(qi, kb, vb, bias, mask)

    o = lax.map(one_chunk, (jnp.arange(nc), qc))
    o = jnp.moveaxis(o, 0, 1).reshape(b, s, ATT_HEADS, ATT_HEAD_DIM)
    rows = min(WINDOW, s)
    return o, k[:, s - rows:], v[:, s - rows:]


def sample_attention(q, k, v, rel_bias, cache_k, cache_v):
    rows, t = cache_k.shape[1], q.shape[1]
    k_all = jnp.concatenate([cache_k.astype(k.dtype), k], axis=1)
    v_all = jnp.concatenate([cache_v.astype(v.dtype), v], axis=1)
    q_pos = PAST_LEN + jnp.arange(t)
    k_pos = PAST_LEN + jnp.arange(-rows, t)
    qc, kc = q_pos // CHUNK, k_pos // CHUNK
    mask = ((kc[None, :] <= qc[:, None]) & (kc[None, :] >= qc[:, None] - BAND_CHUNKS))[None, None]
    o = attend(q, k_all, v_all, rel_bias_for(q_pos, k_pos, rel_bias), mask)
    return o, k, v


def causal_dwconv(u, buf, w, b):
    s = u.shape[1]
    up = jnp.concatenate([buf.astype(u.dtype), u], axis=1)
    y = b
    for j in range(CONV_WIDTH):
        y = y + up[:, j:j + s] * w[j]
    return y, up[:, up.shape[1] - (CONV_WIDTH - 1):]


def ssd_scan(xs, dt, a, bm, cm, h0):
    b, s = xs.shape[:2]
    e = SSD_HEADS // SSD_GROUPS
    ln = min(CHUNK, s)
    nc = s // ln

    def to_chunks(t):
        return jnp.moveaxis(t.reshape((b, nc, ln) + t.shape[2:]), 1, 0)

    xc = to_chunks(xs.reshape(b, s, SSD_GROUPS, e, SSD_HEAD_DIM))
    dtc = to_chunks(dt.reshape(b, s, SSD_GROUPS, e))
    bc, cc = to_chunks(bm), to_chunks(cm)
    ag = a.reshape(SSD_GROUPS, e)
    causal = jnp.tril(jnp.ones((ln, ln), dtype=bool))[None, :, :, None, None]

    def step(h, inp):
        x, d, bk, ck = inp
        a_cs = jnp.cumsum(d * ag, axis=1)
        seg = a_cs[:, :, None] - a_cs[:, None, :]
        decay = jnp.exp(jnp.where(causal, seg, -jnp.inf))
        cb = jnp.einsum('blgn,bsgn->blsg', ck, bk)
        xdt = x * d[..., None]
        y_in = jnp.einsum('blsge,bsgep->blgep', cb[..., None] * decay, xdt)
        y_st = jnp.einsum('blgn,bgepn->blgep', ck, h) * jnp.exp(a_cs)[..., None]
        to_end = jnp.exp(a_cs[:, -1:] - a_cs)
        h_new = h * jnp.exp(a_cs[:, -1])[..., None, None] + jnp.einsum('blgn,blgep->bgepn', bk, xdt * to_end[..., None])
        return h_new, y_in + y_st

    h_fin, yc = lax.scan(step, h0.reshape(b, SSD_GROUPS, e, SSD_HEAD_DIM, SSD_STATE), (xc, dtc, bc, cc))
    y = jnp.moveaxis(yc, 0, 1).reshape(b, s, SSD_HEADS, SSD_HEAD_DIM)
    return y, h_fin.reshape(b, SSD_HEADS, SSD_HEAD_DIM, SSD_STATE)


def trunk_layer(x, c, conv_buf, h0, attn_fn, norm_g, w_ada, b_ada, w_in, q_norm_g, k_norm_g,
                w_att_proj, conv_w, conv_b, dt_bias, a_log, d_skip, ssd_norm_g, w_ssd_proj, w_out):
    b, s = x.shape[:2]
    mod = jax.nn.silu(c) @ w_ada + b_ada
    shift, scale, gate = jnp.split(mod[:, None, :], 3, axis=-1)
    h = rms_norm(x, norm_g) * (1 + scale) + shift
    proj = h @ w_in
    q, k, v, z_att, z_ssd, xbc, dt_raw, gates = jnp.split(proj, IN_SPLITS, axis=-1)
    q = rms_norm(q.reshape(b, s, ATT_HEADS, ATT_HEAD_DIM), q_norm_g)
    k = rms_norm(k.reshape(b, s, ATT_HEADS, ATT_HEAD_DIM), k_norm_g)
    v = v.reshape(b, s, ATT_HEADS, ATT_HEAD_DIM)
    o_att, k_st, v_st = attn_fn(q, k, v)
    att_branch = (o_att.reshape(b, s, ATT_WIDTH) * jax.nn.silu(z_att)) @ w_att_proj
    xbc, conv_new = causal_dwconv(xbc, conv_buf, conv_w, conv_b)
    xbc = jax.nn.silu(xbc)
    xs, bm, cm = jnp.split(xbc, [SSD_WIDTH, SSD_WIDTH + SSD_GROUPS * SSD_STATE], axis=-1)
    xs_h = xs.reshape(b, s, SSD_HEADS, SSD_HEAD_DIM).astype(jnp.float32)
    dt = jax.nn.softplus(dt_raw.astype(jnp.float32) + dt_bias.astype(jnp.float32))
    a = -jnp.exp(a_log.astype(jnp.float32))
    y, h_new = ssd_scan(xs_h, dt, a,
                        bm.reshape(b, s, SSD_GROUPS, SSD_STATE).astype(jnp.float32),
                        cm.reshape(b, s, SSD_GROUPS, SSD_STATE).astype(jnp.float32),
                        h0.astype(jnp.float32))
    y = (y + d_skip.astype(jnp.float32)[:, None] * xs_h).reshape(b, s, SSD_WIDTH).astype(x.dtype)
    y = y * jax.nn.silu(z_ssd)
    y = rms_norm(y.reshape(b, s, SSD_GROUPS, SSD_WIDTH // SSD_GROUPS),
                 ssd_norm_g.reshape(SSD_GROUPS, SSD_WIDTH // SSD_GROUPS)).reshape(b, s, SSD_WIDTH)
    ssd_branch = y @ w_ssd_proj
    g_att, g_ssd = jnp.split(gates, 2, axis=-1)
    merged = jax.nn.sigmoid(g_att) * att_branch + jax.nn.sigmoid(g_ssd) * ssd_branch
    out = x + gate * (merged @ w_out)
    return out, k_st, v_st, conv_new, h_new.astype(h0.dtype)


def setup_inputs(seed: int = 0) -> dict:
    key = jax.random.key(seed)
    ks = jax.random.split(key, 32)
    f32 = jnp.float32
    rows = min(WINDOW, PAST_LEN)
    nrm = lambda k, shp, sc: jax.random.normal(k, shp, f32) * sc
    dt0 = jnp.exp(jax.random.uniform(ks[20], (DEPTH, SSD_HEADS), f32, np.log(1e-3), np.log(1e-1)))
    return {
        "x_prompt": nrm(ks[0], (BATCH, SEQ, D_MODEL), 1.0),
        "x_sample": nrm(ks[1], (DEC_BATCH, DEC_SEQ, D_MODEL), 1.0),
        "c_prompt": nrm(ks[2], (BATCH, D_MODEL), 1.0),
        "c_sample": nrm(ks[3], (DEC_BATCH, D_MODEL), 1.0),
        "cache_k": nrm(ks[4], (DEPTH, DEC_BATCH, rows, ATT_HEADS, ATT_HEAD_DIM), 1.0),
        "cache_v": nrm(ks[5], (DEPTH, DEC_BATCH, rows, ATT_HEADS, ATT_HEAD_DIM), 1.0),
        "state_conv": nrm(ks[6], (DEPTH, DEC_BATCH, CONV_WIDTH - 1, CONV_CH), 1.0),
        "state_ssm": nrm(ks[7], (DEPTH, DEC_BATCH, SSD_HEADS, SSD_HEAD_DIM, SSD_STATE), 0.5),
        "norm_g": 1.0 + nrm(ks[8], (DEPTH, D_MODEL), 0.02),
        "w_ada": nrm(ks[9], (DEPTH, D_MODEL, 3 * D_MODEL), 0.5 * D_MODEL ** -0.5),
        "b_ada": nrm(ks[10], (DEPTH, 3 * D_MODEL), 0.01),
        "w_in": nrm(ks[11], (DEPTH, D_MODEL, IN_DIM), D_MODEL ** -0.5),
        "q_norm_g": 1.0 + nrm(ks[12], (DEPTH, ATT_HEAD_DIM), 0.02),
        "k_norm_g": 1.0 + nrm(ks[13], (DEPTH, ATT_HEAD_DIM), 0.02),
        "rel_bias": nrm(ks[14], (DEPTH, ATT_HEADS, 2 * MAX_REL + 1), 0.1),
        "w_att_proj": nrm(ks[15], (DEPTH, ATT_WIDTH, D_MODEL), ATT_WIDTH ** -0.5),
        "conv_w": nrm(ks[16], (DEPTH, CONV_WIDTH, CONV_CH), CONV_WIDTH ** -0.5),
        "conv_b": nrm(ks[17], (DEPTH, CONV_CH), 0.01),
        "dt_bias": dt0 + jnp.log(-jnp.expm1(-dt0)),
        "a_log": jnp.log(jax.random.uniform(ks[18], (DEPTH, SSD_HEADS), f32, 1.0, 16.0)),
        "d_skip": 1.0 + nrm(ks[19], (DEPTH, SSD_HEADS), 0.1),
        "ssd_norm_g": 1.0 + nrm(ks[21], (DEPTH, SSD_WIDTH), 0.02),
        "w_ssd_proj": nrm(ks[22], (DEPTH, SSD_WIDTH, D_MODEL), SSD_WIDTH ** -0.5),
        "w_out": nrm(ks[23], (DEPTH, D_MODEL, D_MODEL), D_MODEL ** -0.5),
    }


def reference(x_prompt, x_sample, c_prompt, c_sample, cache_k, cache_v, state_conv, state_ssm,
              norm_g, w_ada, b_ada, w_in, q_norm_g, k_norm_g, rel_bias, w_att_proj,
              conv_w, conv_b, dt_bias, a_log, d_skip, ssd_norm_g, w_ssd_proj, w_out):
    xp, xs = x_prompt, x_sample
    kp_l, vp_l, cp_l, hp_l, ks_l, vs_l, cs_l, hs_l = [], [], [], [], [], [], [], []
    for l in range(DEPTH):
        lw = (norm_g[l], w_ada[l], b_ada[l], w_in[l], q_norm_g[l], k_norm_g[l], w_att_proj[l],
              conv_w[l], conv_b[l], dt_bias[l], a_log[l], d_skip[l], ssd_norm_g[l], w_ssd_proj[l], w_out[l])
        conv0 = jnp.zeros((xp.shape[0], CONV_WIDTH - 1, CONV_CH), xp.dtype)
        h0 = jnp.zeros((xp.shape[0], SSD_HEADS, SSD_HEAD_DIM, SSD_STATE), state_ssm.dtype)
        xp, kp, vp, cp, hp = trunk_layer(xp, c_prompt, conv0, h0,
                                         functools.partial(prompt_attention, rel_bias=rel_bias[l]), *lw)
        xs, ks, vs, cs, hs = trunk_layer(xs, c_sample, state_conv[l], state_ssm[l],
                                         functools.partial(sample_attention, rel_bias=rel_bias[l],
                                                           cache_k=cache_k[l], cache_v=cache_v[l]), *lw)
        kp_l.append(kp); vp_l.append(vp); cp_l.append(cp); hp_l.append(hp)
        ks_l.append(ks); vs_l.append(vs); cs_l.append(cs); hs_l.append(hs)
    return (xp, xs, jnp.stack(kp_l), jnp.stack(vp_l), jnp.stack(cp_l), jnp.stack(hp_l),
            jnp.stack(ks_l), jnp.stack(vs_l), jnp.stack(cs_l), jnp.stack(hs_l))
```

```cpp
#include <hip/hip_runtime.h>
#include <hip/hip_cooperative_groups.h>
#include <cstdio>
#include <cstdint>
namespace cg = cooperative_groups;

#define LAS __attribute__((address_space(3)))
typedef unsigned short bf16_t;
typedef short bf16x8 __attribute__((ext_vector_type(8)));
typedef float f32x4 __attribute__((ext_vector_type(4)));
typedef float f32x2 __attribute__((ext_vector_type(2)));
typedef unsigned u32x4 __attribute__((ext_vector_type(4)));
typedef unsigned u32x2 __attribute__((ext_vector_type(2)));

constexpr int DM = 1024, T_P = 32768, T_S = 128, T_ALL = T_P + T_S, M_PAD = 33024;
constexpr int SEQ = 8192, NB = 4, NSB = 8, TS = 16;
constexpr int N_IN = 11296, NT1 = 24, NT2 = 21, N_WIN = (NT1 + NT2) * 256;
constexpr int CONVC = 3072, SSDW = 2048;
constexpr float EPS = 1e-6f, LOG2E = 1.4426950408889634f, QSCALE = 0.125f * 1.4426950408889634f;
constexpr size_t O_YP = 0, O_YS = O_YP + (size_t)T_P * DM, O_KP = O_YS + (size_t)T_S * DM, O_VP = O_KP + (size_t)NB * 512 * 1024,
                 O_CP = O_VP + (size_t)NB * 512 * 1024, O_HP = O_CP + (size_t)NB * 3 * CONVC, O_KS = O_HP + (size_t)NB * 32 * 64 * 128,
                 O_VS = O_KS + (size_t)T_S * 1024, O_CS = O_VS + (size_t)T_S * 1024, O_HS = O_CS + (size_t)NSB * 3 * CONVC,
                 O_END = O_HS + (size_t)NSB * 32 * 64 * 128;
constexpr size_t MiB = 1u << 20;
constexpr size_t WS_MOD = 0, WS_SSQ = 256 * 1024, WS_WIN = 1 * MiB, WS_WATT = 24 * MiB, WS_WSSD = 26 * MiB, WS_WOUT = 30 * MiB,
                 WS_HALO = 32 * MiB, WS_XBCS = 42 * MiB, WS_H = 43 * MiB, ROWB = (size_t)M_PAD * 1024 * 2  ,
                 WS_Q = WS_H + ROWB, WS_R = WS_Q + ROWB, WS_K = WS_R, WS_V = WS_R + ROWB, WS_ZA = WS_R + 2 * ROWB, WS_XBC = WS_R,
                 WS_ZS = WS_R + 3 * ROWB, WS_DT = WS_ZS + 2 * ROWB, WS_SSQP = WS_DT + (size_t)M_PAD * 32 * 4  , WS_SSQS = WS_SSQP + (size_t)32 * T_P * 4  , WS_END = WS_SSQS + (size_t)NSB * 32 * 32 * 4;
constexpr size_t WS_SST0 = WS_HALO, WS_SST1 = WS_HALO + 4 * MiB, WS_ACUM = WS_HALO + 8 * MiB, WS_ATOT = WS_SSQ;
static_assert(WS_END <= 512 * MiB, "workspace map");
static_assert(WS_SSQ + (size_t)T_ALL * 16 <= WS_WIN && WS_WIN + (size_t)N_WIN * 1024 * 2 <= WS_WATT, "ws map");
constexpr int LDS_BYTES = 147456;

typedef __bf16 bf16x2_t __attribute__((ext_vector_type(2)));
__device__ __forceinline__ unsigned cvt_pk_bf16(float lo, float hi) { const f32x2 v = {lo, hi}; const bf16x2_t b = __builtin_convertvector(v, bf16x2_t); return __builtin_bit_cast(unsigned, b); }
__device__ __forceinline__ void store16_wt(void* p, u32x4 v) { asm volatile("global_store_dwordx4 %0, %1, off sc0 sc1" :: "v"(p), "v"(v) : "memory"); }
__device__ __forceinline__ int tid_opaque() { int t = threadIdx.x; asm volatile("" : "+v"(t)); return t; }
__device__ __forceinline__ float bf_lo(unsigned w) { return __uint_as_float(w << 16); }
__device__ __forceinline__ float bf_hi(unsigned w) { return __uint_as_float(w & 0xffff0000u); }
__device__ __forceinline__ float silu_f(float x) { return x * __builtin_amdgcn_rcpf(1.f + __expf(-x)); }
__device__ __forceinline__ float sigmoid_f(float x) { return __builtin_amdgcn_rcpf(1.f + __expf(-x)); }
__device__ __forceinline__ f32x4 mfma16(bf16x8 a, bf16x8 b, f32x4 c) { return __builtin_amdgcn_mfma_f32_16x16x32_bf16(a, b, c, 0, 0, 0); }
__device__ __forceinline__ u32x4 pack8(const float* v) { u32x4 w; w.x = cvt_pk_bf16(v[0], v[1]); w.y = cvt_pk_bf16(v[2], v[3]); w.z = cvt_pk_bf16(v[4], v[5]); w.w = cvt_pk_bf16(v[6], v[7]); return w; }
__device__ __forceinline__ unsigned pk16(const u32x4& a, const u32x4& b, int dd) {
    const unsigned wa = (dd >> 1) == 0 ? a.x : (dd >> 1) == 1 ? a.y : (dd >> 1) == 2 ? a.z : a.w, wb = (dd >> 1) == 0 ? b.x : (dd >> 1) == 1 ? b.y : (dd >> 1) == 2 ? b.z : b.w;
    return (dd & 1) ? __builtin_amdgcn_perm(wb, wa, 0x07060302u) : __builtin_amdgcn_perm(wb, wa, 0x05040100u);
}
__device__ __forceinline__ unsigned el16(const u32x4& v, int dd) { const unsigned w = (dd >> 1) == 0 ? v.x : (dd >> 1) == 1 ? v.y : (dd >> 1) == 2 ? v.z : v.w; return (dd & 1) ? (w >> 16) : (w & 0xffffu); }

namespace pg8 {
#define PG8_LAS __attribute__((address_space(3)))
constexpr int BM = 256, BK = 64, HALF = 128, HTB = HALF * BK * 2, STAGE_BYTES = 8 * HTB, NXCD = 8, WGM = 8;
__host__ __device__ __forceinline__ int lds_byte(int r, int c) { const int st = (r >> 4) * 2 + (c >> 5), rr = r & 15, cc = c & 31, ob = rr * 64 + cc * 2; return st * 1024 + (ob ^ (((ob >> 9) & 1) << 5)); }
__host__ __device__ __forceinline__ void stage_rc(int b, int& R, int& C) { const int st = b / 1024, sb = b % 1024, swz = sb ^ (((sb >> 9) & 1) << 5); R = (st >> 1) * 16 + swz / 64; C = (st & 1) * 32 + (swz % 64) / 2; }
__host__ __device__ __forceinline__ int perm32(int rho) { const int n = rho >> 4, i = rho & 15; return 8 * (i >> 2) + 4 * n + (i & 3); }
struct Unit { int pm, pn; };
struct Gemm { const bf16_t* A; const bf16_t* Bt; int M, N, K; };
struct StaticOrder {
    int nM, nN, nwg, G, c;
    __host__ __device__ void init(int M, int N, int G_, int c_) { nM = M / BM; nN = N / BM; nwg = nM * nN; G = G_; c = c_; }
    __host__ __device__ bool next(int i, Unit& u) const {
        const long L = (long)i * G + c; if (L >= nwg) return false;
        int wgid = (int)L; { const int q = nwg / NXCD, r = nwg % NXCD, xcd = wgid % NXCD, off = wgid / NXCD; wgid = (xcd < r ? xcd * (q + 1) : r * (q + 1) + (xcd - r) * q) + off; }
        const int nig = WGM * nN, gid = wgid / nig, fm = gid * WGM, gsz = (nM - fm) < WGM ? (nM - fm) : WGM;
        u.pm = fm + ((wgid % nig) % gsz); u.pn = (wgid % nig) / gsz; return true;
    }
    __device__ __forceinline__ void a_ready(const Unit&) const {}
    __device__ __forceinline__ void done(const Unit&) const {}
};
template <class Epi, class Sched, bool ALIGN_EPI = false, bool SP2 = false>
__device__ __forceinline__ void gemm_phase(PG8_LAS unsigned char* lds, const Gemm g, const Sched& S, const Epi& E) {
    int tid_ = threadIdx.x; asm volatile("" : "+v"(tid_));
    const int tid = tid_, wid = __builtin_amdgcn_readfirstlane(tid >> 6), lane = tid & 63, wr = wid >> 2, wc = wid & 3, fr = lane & 15, fq = lane >> 4;
    const int K = g.K, nt = K / BK;
    unsigned voffA[2], voffB[2];
#pragma unroll
    for (int i = 0; i < 2; ++i) { int R, C; stage_rc(tid * 16 + i * 8192, R, C); const int Rb = Epi::PERM ? ((R & ~31) + perm32(R & 31)) : R;
        voffA[i] = (unsigned)(R * K + C) * 2u; voffB[i] = (unsigned)(Rb * K + C) * 2u; }
    const size_t kstep = (size_t)(BK * 2);
    const size_t hstep = (size_t)HALF * K * 2;
    const size_t tstep = 2 * hstep;
    const unsigned ldsw = (unsigned)wid * 1024u;
    const int aoff = lds_byte(wr * 64 + fr, fq * 8), boff = lds_byte(wc * 32 + fr, fq * 8);
#define PG8_SA(b, h) (((b) * 2 + (h)) * HTB)
#define PG8_SB(b, h) ((4 + (b) * 2 + (h)) * HTB)
#define PG8_STAGE(bufoff, gbase, voff) do { _Pragma("unroll") for (int _i = 0; _i < 2; ++_i) \
        __builtin_amdgcn_global_load_lds((const unsigned*)((const char*)(gbase) + (voff)[_i]), (PG8_LAS unsigned*)(lds + (bufoff) + ldsw + _i * 8192), 16, 0, 0); } while (0)
#define PG8_LDA(dst, b, h) do { _Pragma("unroll") for (int m = 0; m < 4; ++m) _Pragma("unroll") for (int k = 0; k < 2; ++k) dst[m][k] = *(const PG8_LAS bf16x8*)(lds + PG8_SA(b, h) + aoff + m * 2048 + k * 1024); } while (0)
#define PG8_LDB(dst, b, h) do { _Pragma("unroll") for (int n = 0; n < 2; ++n) _Pragma("unroll") for (int k = 0; k < 2; ++k) dst[n][k] = *(const PG8_LAS bf16x8*)(lds + PG8_SB(b, h) + boff + n * 2048 + k * 1024); } while (0)
#define PG8_MMA(ai, bj, At, Bt) do { __builtin_amdgcn_s_setprio(1); _Pragma("unroll") for (int m = 0; m < 4; ++m) _Pragma("unroll") for (int n = 0; n < 2; ++n) _Pragma("unroll") for (int k = 0; k < 2; ++k) \
        acc[ai][bj][m][n] = __builtin_amdgcn_mfma_f32_16x16x32_bf16(Bt[n][k], At[m][k], acc[ai][bj][m][n], 0, 0, 0); __builtin_amdgcn_s_setprio(0); } while (0)
#define PG8_WAIT_V(n) asm volatile("s_waitcnt vmcnt(" #n ")" ::: "memory")
#define PG8_WAIT_L(n) asm volatile("s_waitcnt lgkmcnt(" #n ")" ::: "memory")
#define PG8_BAR __builtin_amdgcn_s_barrier()
#define PG8_SCHED __builtin_amdgcn_sched_barrier(0)
    Unit cur, nxt; int ui = 0;
    if (!S.next(0, cur)) return;
    f32x4 acc[2][2][4][2];
#pragma unroll
    for (int a = 0; a < 2; ++a)
#pragma unroll
        for (int b = 0; b < 2; ++b)
#pragma unroll
            for (int m = 0; m < 4; ++m)
#pragma unroll
                for (int n = 0; n < 2; ++n) acc[a][b][m][n] = (f32x4){0.f, 0.f, 0.f, 0.f};
    bf16x8 At[4][2], B0[2][2], B1[2][2];
    const char* cA = (const char*)g.A + (size_t)cur.pm * tstep; const char* cB = (const char*)g.Bt + (size_t)cur.pn * tstep;
    S.a_ready(cur);
    if constexpr (SP2) {
        PG8_STAGE(PG8_SB(0, 0), cB, voffB); PG8_STAGE(PG8_SB(0, 1), cB + hstep, voffB); PG8_STAGE(PG8_SA(0, 0), cA, voffA); PG8_STAGE(PG8_SA(0, 1), cA + hstep, voffA);
        if (wr == 1) PG8_BAR;
        PG8_WAIT_V(2); PG8_BAR;
        PG8_STAGE(PG8_SB(1, 0), cB + kstep, voffB); PG8_STAGE(PG8_SA(1, 0), cA + kstep, voffA); PG8_STAGE(PG8_SB(1, 1), cB + hstep + kstep, voffB);
        PG8_WAIT_V(6); PG8_BAR;
    } else {
        PG8_STAGE(PG8_SB(0, 0), cB, voffB); PG8_STAGE(PG8_SA(0, 0), cA, voffA); PG8_STAGE(PG8_SB(0, 1), cB + hstep, voffB); PG8_STAGE(PG8_SA(0, 1), cA + hstep, voffA);
        if (wr == 1) PG8_BAR;
        PG8_WAIT_V(4); PG8_BAR;
        PG8_STAGE(PG8_SB(1, 0), cB + kstep, voffB); PG8_STAGE(PG8_SA(1, 0), cA + kstep, voffA); PG8_STAGE(PG8_SB(1, 1), cB + hstep + kstep, voffB);
        PG8_WAIT_V(6); PG8_BAR;
    }
    for (;;) {
        const bool has_next = S.next(ui + 1, nxt);
        const char* nA = has_next ? (const char*)g.A + (size_t)nxt.pm * tstep : cA; const char* nB = has_next ? (const char*)g.Bt + (size_t)nxt.pn * tstep : cB;
        for (int t = 0; t < nt; t += 2) {
            const bool last = (t == nt - 2);
            const char* a1 = cA + (size_t)(t + 1) * kstep;
            const char* a2 = last ? nA : cA + (size_t)(t + 2) * kstep; const char* b2 = last ? nB : cB + (size_t)(t + 2) * kstep;
            const char* a3 = a2 + kstep; const char* b3 = b2 + kstep;
            if (last && has_next) S.a_ready(nxt);
            if constexpr (SP2) {
            PG8_LDB(B0, 0, 0); PG8_LDB(B1, 0, 1); PG8_SCHED; PG8_LDA(At, 0, 0); PG8_STAGE(PG8_SA(1, 1), a1 + hstep, voffA);
            PG8_WAIT_V(8); PG8_WAIT_L(0); PG8_BAR; PG8_MMA(0, 0, At, B0); PG8_MMA(0, 1, At, B1); PG8_BAR; PG8_SCHED;
            PG8_LDA(At, 0, 1); PG8_STAGE(PG8_SB(0, 0), b2, voffB); PG8_STAGE(PG8_SB(0, 1), b2 + hstep, voffB); PG8_STAGE(PG8_SA(0, 0), a2, voffA);
            PG8_WAIT_V(8); PG8_WAIT_L(0); PG8_BAR; PG8_MMA(1, 0, At, B0); PG8_MMA(1, 1, At, B1); PG8_BAR; PG8_SCHED;
            PG8_LDB(B0, 1, 0); PG8_LDB(B1, 1, 1); PG8_SCHED; PG8_LDA(At, 1, 0); PG8_STAGE(PG8_SA(0, 1), a2 + hstep, voffA);
            PG8_WAIT_V(8); PG8_WAIT_L(0); PG8_BAR; PG8_MMA(0, 0, At, B0); PG8_MMA(0, 1, At, B1); PG8_BAR; PG8_SCHED;
            PG8_LDA(At, 1, 1); PG8_STAGE(PG8_SB(1, 0), b3, voffB); PG8_STAGE(PG8_SB(1, 1), b3 + hstep, voffB); PG8_STAGE(PG8_SA(1, 0), a3, voffA);
            PG8_WAIT_V(8); PG8_WAIT_L(0); PG8_BAR; PG8_MMA(1, 0, At, B0); PG8_MMA(1, 1, At, B1); PG8_BAR; PG8_SCHED;
            } else {
            PG8_LDB(B0, 0, 0); PG8_SCHED; PG8_LDA(At, 0, 0); PG8_STAGE(PG8_SA(1, 1), a1 + hstep, voffA);
            PG8_WAIT_L(8); PG8_BAR; PG8_WAIT_L(0); PG8_MMA(0, 0, At, B0); PG8_BAR; PG8_SCHED;
            PG8_LDB(B1, 0, 1); PG8_STAGE(PG8_SB(0, 0), b2, voffB);
            PG8_BAR; PG8_WAIT_L(0); PG8_MMA(0, 1, At, B1); PG8_BAR;
            PG8_LDA(At, 0, 1); PG8_STAGE(PG8_SA(0, 0), a2, voffA);
            PG8_BAR; PG8_WAIT_L(0); PG8_MMA(1, 0, At, B0); PG8_BAR; PG8_SCHED;
            PG8_STAGE(PG8_SB(0, 1), b2 + hstep, voffB);
            PG8_WAIT_V(6); PG8_BAR; PG8_MMA(1, 1, At, B1); PG8_BAR;
            PG8_LDB(B0, 1, 0); PG8_SCHED; PG8_LDA(At, 1, 0); PG8_STAGE(PG8_SA(0, 1), a2 + hstep, voffA);
            PG8_WAIT_L(8); PG8_BAR; PG8_WAIT_L(0); PG8_MMA(0, 0, At, B0); PG8_BAR; PG8_SCHED;
            PG8_LDB(B1, 1, 1); PG8_STAGE(PG8_SB(1, 0), b3, voffB);
            PG8_BAR; PG8_WAIT_L(0); PG8_MMA(0, 1, At, B1); PG8_BAR;
            PG8_LDA(At, 1, 1); PG8_STAGE(PG8_SA(1, 0), a3, voffA);
            PG8_BAR; PG8_WAIT_L(0); PG8_MMA(1, 0, At, B0); PG8_BAR; PG8_SCHED;
            PG8_STAGE(PG8_SB(1, 1), b3 + hstep, voffB);
            PG8_WAIT_V(6); PG8_BAR; PG8_MMA(1, 1, At, B1); PG8_BAR;
            }
        }
        if constexpr (ALIGN_EPI) { if (wr == 0) PG8_BAR; }
        E(acc, cur, wr, wc, fr, fq); S.done(cur);
        if (!has_next) break;
#pragma unroll
        for (int a = 0; a < 2; ++a)
#pragma unroll
            for (int b = 0; b < 2; ++b)
#pragma unroll
                for (int m = 0; m < 4; ++m)
#pragma unroll
                    for (int n = 0; n < 2; ++n) acc[a][b][m][n] = (f32x4){0.f, 0.f, 0.f, 0.f};
        cur = nxt; cA = nA; cB = nB; ++ui;
        if constexpr (ALIGN_EPI) { if (wr == 1) PG8_BAR; }
    }
    PG8_WAIT_V(0);
    if constexpr (!ALIGN_EPI) { if (wr == 0) PG8_BAR; }
    PG8_BAR;
#undef PG8_SA
#undef PG8_SB
#undef PG8_STAGE
#undef PG8_LDA
#undef PG8_LDB
#undef PG8_MMA
#undef PG8_WAIT_V
#undef PG8_WAIT_L
#undef PG8_BAR
#undef PG8_SCHED
}
}
using pg8::Unit;

#define EPI_ROW(u, ai, wr, m, fr) ((u).pm * 256 + (ai) * 128 + (wr) * 64 + (m) * 16 + (fr))

struct EpiIn1 {
    static constexpr bool PERM = true, AFTER_DRAIN = false;
    bf16_t *Q, *K, *V, *ZA; unsigned char* gates; float* out; const float *qg, *kg;
    __device__ __forceinline__ void operator()(const f32x4 (&acc)[2][2][4][2], const Unit& u, int wr, int wc, int fr, int fq) const {
        const int pn = u.pn, seg = pn >> 2;
        if (seg <= 1) {
            const float* gv = seg == 0 ? qg : kg; const float sc = seg == 0 ? QSCALE : 1.f;
            float g[2][8];
#pragma unroll
            for (int bj = 0; bj < 2; ++bj)
#pragma unroll
                for (int e = 0; e < 8; ++e) g[bj][e] = gv[32 * bj + 8 * fq + e] * sc;
            const int colbase = (pn & 3) * 256 + 64 * wc + 8 * fq;
            bf16_t* dstb = seg == 0 ? Q : K;
#pragma unroll
            for (int ai = 0; ai < 2; ++ai)
#pragma unroll
                for (int m = 0; m < 4; ++m) {
                    float ss = 0.f;
#pragma unroll
                    for (int bj = 0; bj < 2; ++bj)
#pragma unroll
                        for (int n = 0; n < 2; ++n) { const f32x4 v = acc[ai][bj][m][n]; ss += (v[0] * v[0] + v[1] * v[1]) + (v[2] * v[2] + v[3] * v[3]); }
                    ss += __shfl_xor(ss, 16); ss += __shfl_xor(ss, 32);
                    const float rinv = rsqrtf(ss * (1.f / 64.f) + EPS);
                    const int row = EPI_ROW(u, ai, wr, m, fr);
#pragma unroll
                    for (int bj = 0; bj < 2; ++bj) {
                        float o[8];
#pragma unroll
                        for (int e = 0; e < 8; ++e) o[e] = acc[ai][bj][m][e >> 2][e & 3] * rinv * g[bj][e];
                        const int col = colbase + 32 * bj;
                        *(u32x4*)(dstb + (size_t)row * 1024 + col) = pack8(o);
                        if (seg == 1) {
                            float* d = nullptr;
                            if (row < T_P) { const int s = row & (SEQ - 1); if (s >= SEQ - 512) d = out + O_KP + ((size_t)((row >> 13) * 512 + s - (SEQ - 512)) * 1024 + col); }
                            else if (row < T_ALL) d = out + O_KS + ((size_t)(row - T_P) * 1024 + col);
                            if (d) { *(f32x4*)d = (f32x4){o[0], o[1], o[2], o[3]}; *(f32x4*)(d + 4) = (f32x4){o[4], o[5], o[6], o[7]}; }
                        }
                    }
                }
        } else if (seg <= 3) {
            const int colbase = (pn & 3) * 256 + 64 * wc + 8 * fq;
            bf16_t* dstb = seg == 2 ? V : ZA;
#pragma unroll
            for (int ai = 0; ai < 2; ++ai)
#pragma unroll
                for (int m = 0; m < 4; ++m) {
                    const int row = EPI_ROW(u, ai, wr, m, fr);
#pragma unroll
                    for (int bj = 0; bj < 2; ++bj) {
                        float o[8];
#pragma unroll
                        for (int e = 0; e < 8; ++e) { const float v = acc[ai][bj][m][e >> 2][e & 3]; o[e] = seg == 2 ? v : silu_f(v); }
                        const int col = colbase + 32 * bj;
                        *(u32x4*)(dstb + (size_t)row * 1024 + col) = pack8(o);
                        if (seg == 2) {
                            float* d = nullptr;
                            if (row < T_P) { const int s = row & (SEQ - 1); if (s >= SEQ - 512) d = out + O_VP + ((size_t)((row >> 13) * 512 + s - (SEQ - 512)) * 1024 + col); }
                            else if (row < T_ALL) d = out + O_VS + ((size_t)(row - T_P) * 1024 + col);
                            if (d) { *(f32x4*)d = (f32x4){o[0], o[1], o[2], o[3]}; *(f32x4*)(d + 4) = (f32x4){o[4], o[5], o[6], o[7]}; }
                        }
                    }
                }
        } else {
            const int colbase = (pn - 16) * 256 + 64 * wc + 8 * fq;
#pragma unroll
            for (int ai = 0; ai < 2; ++ai)
#pragma unroll
                for (int m = 0; m < 4; ++m) {
                    const int row = EPI_ROW(u, ai, wr, m, fr);
                    if (row < T_ALL) {
#pragma unroll
                        for (int bj = 0; bj < 2; ++bj) {
                            float o[8];
#pragma unroll
                            for (int e = 0; e < 8; ++e) o[e] = sigmoid_f(acc[ai][bj][m][e >> 2][e & 3]);
                            *(u32x4*)(gates + (size_t)row * 4096 + (size_t)(colbase + 32 * bj) * 2) = pack8(o);
                        }
                    }
                }
        }
    }
};

struct EpiIn2 {
    static constexpr bool PERM = true, AFTER_DRAIN = false;
    bf16_t *ZS, *XBC, *HALO; float* DT; float* out; const float* dt_bias;
    __device__ __forceinline__ void operator()(const f32x4 (&acc)[2][2][4][2], const Unit& u, int wr, int wc, int fr, int fq) const {
        const int pn = u.pn;
        if (pn < 8) {
            const int colbase = pn * 256 + 64 * wc + 8 * fq;
#pragma unroll
            for (int ai = 0; ai < 2; ++ai)
#pragma unroll
                for (int m = 0; m < 4; ++m) {
                    const int row = EPI_ROW(u, ai, wr, m, fr);
#pragma unroll
                    for (int bj = 0; bj < 2; ++bj) {
                        float o[8];
#pragma unroll
                        for (int e = 0; e < 8; ++e) o[e] = silu_f(acc[ai][bj][m][e >> 2][e & 3]);
                        *(u32x4*)(ZS + (size_t)row * SSDW + colbase + 32 * bj) = pack8(o);
                    }
                }
        } else if (pn < 20) {
            const int colbase = (pn - 8) * 256 + 64 * wc + 8 * fq;
#pragma unroll
            for (int ai = 0; ai < 2; ++ai)
#pragma unroll
                for (int m = 0; m < 4; ++m) {
                    const int row = EPI_ROW(u, ai, wr, m, fr);
#pragma unroll
                    for (int bj = 0; bj < 2; ++bj) {
                        float o[8];
#pragma unroll
                        for (int e = 0; e < 8; ++e) o[e] = acc[ai][bj][m][e >> 2][e & 3];
                        const int col = colbase + 32 * bj;
                        const u32x4 w = pack8(o);
                        *(u32x4*)(XBC + (size_t)row * CONVC + col) = w;
                        if (m == 3 && fr >= 13) {
                            *(u32x4*)(HALO + ((size_t)(row >> 6) * 3 + (fr - 13)) * CONVC + col) = w;
                            if (row < T_P && (row & (SEQ - 1)) >= SEQ - 3) {
                                float* d = out + O_CP + ((size_t)((row >> 13) * 3 + (fr - 13)) * CONVC + col);
                                *(f32x4*)d = (f32x4){o[0], o[1], o[2], o[3]}; *(f32x4*)(d + 4) = (f32x4){o[4], o[5], o[6], o[7]};
                            }
                        }
                        if (fr >= 13 && row >= T_P && row < T_ALL) {
                            float* d = out + O_CS + ((size_t)(((row - T_P) >> 4) * 3 + (fr - 13)) * CONVC + col);
                            *(f32x4*)d = (f32x4){o[0], o[1], o[2], o[3]}; *(f32x4*)(d + 4) = (f32x4){o[4], o[5], o[6], o[7]};
                        }
                    }
                }
        } else {
            if (wc == 0) {
                float bb[8];
#pragma unroll
                for (int e = 0; e < 8; ++e) bb[e] = dt_bias[8 * fq + e];
#pragma unroll
                for (int ai = 0; ai < 2; ++ai)
#pragma unroll
                    for (int m = 0; m < 4; ++m) {
                        const int row = EPI_ROW(u, ai, wr, m, fr);
                        float o[8];
#pragma unroll
                        for (int e = 0; e < 8; ++e) { const float v = acc[ai][0][m][e >> 2][e & 3] + bb[e]; o[e] = v > 20.f ? v : log1pf(__expf(v)); }
                        float* d = DT + (size_t)row * 32 + 8 * fq;
                        *(f32x4*)d = (f32x4){o[0], o[1], o[2], o[3]}; *(f32x4*)(d + 4) = (f32x4){o[4], o[5], o[6], o[7]};
                    }
            }
        }
    }
};

struct EpiA {
    static constexpr bool PERM = true, AFTER_DRAIN = false;
    bf16_t* Mo; const unsigned char* gates;
    __device__ __forceinline__ void operator()(const f32x4 (&acc)[2][2][4][2], const Unit& u, int wr, int wc, int fr, int fq) const {
        const int colbase = u.pn * 256 + 64 * wc + 8 * fq;
#pragma unroll
        for (int ai = 0; ai < 2; ++ai)
#pragma unroll
            for (int m = 0; m < 4; ++m) {
                const int row = EPI_ROW(u, ai, wr, m, fr);
#pragma unroll
                for (int bj = 0; bj < 2; ++bj) {
                    const int col = colbase + 32 * bj;
                    u32x4 gw = (u32x4){0u, 0u, 0u, 0u};
                    if (row < T_ALL) gw = *(const u32x4*)(gates + (size_t)row * 4096 + (size_t)col * 2);
                    const unsigned gws[4] = {gw.x, gw.y, gw.z, gw.w};
                    float o[8];
#pragma unroll
                    for (int e = 0; e < 8; ++e) { const float gg = (e & 1) ? bf_hi(gws[e >> 1]) : bf_lo(gws[e >> 1]); o[e] = gg * acc[ai][bj][m][e >> 2][e & 3]; }
                    *(u32x4*)(Mo + (size_t)row * 1024 + col) = pack8(o);
                }
            }
    }
};
struct EpiB {
    static constexpr bool PERM = true, AFTER_DRAIN = false;
    bf16_t* Mo; const unsigned char* gates;
    __device__ __forceinline__ void operator()(const f32x4 (&acc)[2][2][4][2], const Unit& u, int wr, int wc, int fr, int fq) const {
        const int colbase = u.pn * 256 + 64 * wc + 8 * fq;
#pragma unroll
        for (int ai = 0; ai < 2; ++ai)
#pragma unroll
            for (int m = 0; m < 4; ++m) {
                const int row = EPI_ROW(u, ai, wr, m, fr);
#pragma unroll
                for (int bj = 0; bj < 2; ++bj) {
                    const int col = colbase + 32 * bj;
                    u32x4 gw = (u32x4){0u, 0u, 0u, 0u};
                    if (row < T_ALL) gw = *(const u32x4*)(gates + (size_t)row * 4096 + (size_t)(1024 + col) * 2);
                    const u32x4 mw = *(const u32x4*)(Mo + (size_t)row * 1024 + col);
                    const unsigned gws[4] = {gw.x, gw.y, gw.z, gw.w}, mws[4] = {mw.x, mw.y, mw.z, mw.w};
                    float o[8];
#pragma unroll
                    for (int e = 0; e < 8; ++e) { const float gg = (e & 1) ? bf_hi(gws[e >> 1]) : bf_lo(gws[e >> 1]); const float mm = (e & 1) ? bf_hi(mws[e >> 1]) : bf_lo(mws[e >> 1]);
                        o[e] = mm + gg * acc[ai][bj][m][e >> 2][e & 3]; }
                    *(u32x4*)(Mo + (size_t)row * 1024 + col) = pack8(o);
                }
            }
    }
};
struct EpiOut {
    static constexpr bool PERM = true, AFTER_DRAIN = false;
    float* out; const float *xp, *xs; const float* mod;
    __device__ __forceinline__ void operator()(const f32x4 (&acc)[2][2][4][2], const Unit& u, int wr, int wc, int fr, int fq) const {
        const int colbase = u.pn * 256 + 64 * wc + 8 * fq;
#pragma unroll
        for (int ai = 0; ai < 2; ++ai)
#pragma unroll
            for (int m = 0; m < 4; ++m) {
                const int row = EPI_ROW(u, ai, wr, m, fr);
                if (row < T_ALL) {
                    const int r12 = row < T_P ? (row >> 13) : 4 + ((row - T_P) >> 4);
                    const float* xr = row < T_P ? xp + (size_t)row * 1024 : xs + (size_t)(row - T_P) * 1024;
#pragma unroll
                    for (int bj = 0; bj < 2; ++bj) {
                        const int col = colbase + 32 * bj;
#pragma unroll
                        for (int n = 0; n < 2; ++n) {
                            const f32x4 xv = *(const f32x4*)(xr + col + 4 * n);
                            const f32x4 gv = *(const f32x4*)(mod + (size_t)r12 * 3072 + 2048 + col + 4 * n);
                            *(f32x4*)(out + (size_t)row * 1024 + col + 4 * n) = xv + gv * acc[ai][bj][m][n];
                        }
                    }
                }
            }
    }
};

struct Args { const float* in[24]; float* out; unsigned char* ws; };
typedef const Args __attribute__((address_space(4)))* KArgsPtr;
__device__ __forceinline__ Args kargs() {
#if defined(__HIP_DEVICE_COMPILE__)
    KArgsPtr p = (KArgsPtr)__builtin_amdgcn_kernarg_segment_ptr(); asm volatile("" : "+s"(p));
    Args r; for (int i = 0; i < 24; ++i) r.in[i] = p->in[i]; r.out = p->out; r.ws = p->ws; return r;
#else
    return Args{};
#endif
}

__device__ __forceinline__ int win_src_col(int np) {
    const int T = np >> 8, p = np & 255;
    const int j = 64 * ((p >> 5) & 3) + 32 * (p >> 7) + (p & 31);
    if (T < 16) return T * 256 + j;
    if (T < 24) return 9248 + (T - 16) * 256 + j;
    if (T < 32) return 4096 + (T - 24) * 256 + j;
    if (T < 44) return 6144 + (T - 32) * 256 + j;
    return j < 32 ? 9216 + j : -1;
}
__device__ __forceinline__ int gen_src_col(int np) { const int p = np & 255; return (np & ~255) + 64 * ((p >> 5) & 3) + 32 * (p >> 7) + (p & 31); }

__device__ __forceinline__ void transpose_item(const float* W, int K, int Nsrc, bf16_t* WT, int np0, int src0, int k0, const float* kscale, LAS float* scr, int lane) {
    float vv[32];
#pragma unroll
    for (int i = 0; i < 32; ++i) { const int kk = 2 * i + (lane >> 5); vv[i] = 0.f;
        if (src0 >= 0) vv[i] = W[(size_t)(k0 + kk) * Nsrc + src0 + (lane & 31)]; }
#pragma unroll
    for (int i = 0; i < 32; ++i) { const int kk = 2 * i + (lane >> 5); float v = vv[i];
        if (src0 >= 0 && kscale) v *= kscale[k0 + kk];
        scr[kk * 33 + (lane & 31)] = v; }
    asm volatile("s_waitcnt lgkmcnt(0)" ::: "memory");
    const int c = lane & 7;
#pragma unroll
    for (int j = 0; j < 4; ++j) { const int n = (lane >> 3) + 8 * j; const LAS float* s = scr + (8 * c) * 33 + n;
        u32x4 o; o.x = cvt_pk_bf16(s[0 * 33], s[1 * 33]); o.y = cvt_pk_bf16(s[2 * 33], s[3 * 33]); o.z = cvt_pk_bf16(s[4 * 33], s[5 * 33]); o.w = cvt_pk_bf16(s[6 * 33], s[7 * 33]);
        *(u32x4*)(WT + (size_t)(np0 + n) * K + k0 + 8 * c) = o; }
    asm volatile("s_waitcnt lgkmcnt(0)" ::: "memory");
}

__device__ __forceinline__ void phase0(LAS unsigned char* L) {
    const Args a = kargs();
    const int tid = tid_opaque(), lane = tid & 63, wave = tid >> 6;
    unsigned char* ws = a.ws;
    float* mod = (float*)(ws + WS_MOD);
    if (blockIdx.x < 96) {
        LAS float* sc = (LAS float*)L; LAS float* red = (LAS float*)(L + 49152);
        for (int i = tid; i < 12 * 1024; i += 512) { const int r = i >> 10, k = i & 1023; const float c = r < 4 ? a.in[2][r * 1024 + k] : a.in[3][(r - 4) * 1024 + k]; sc[i] = silu_f(c); }
        __syncthreads();
        const float* w_ada = a.in[9]; const float* b_ada = a.in[10];
        for (int item = blockIdx.x; item < 96; item += gridDim.x) {
            const int cc = tid & 31, kq = tid >> 5, col = 32 * item + cc;
            float acc[12];
#pragma unroll
            for (int r = 0; r < 12; ++r) acc[r] = 0.f;
#pragma unroll 8
            for (int kk = 0; kk < 64; ++kk) { const int k = 64 * kq + kk; const float w = w_ada[(size_t)k * 3072 + col];
#pragma unroll
                for (int r = 0; r < 12; ++r) acc[r] += sc[r * 1024 + k] * w; }
#pragma unroll
            for (int r = 0; r < 12; ++r) red[(kq * 32 + cc) * 12 + r] = acc[r];
            __syncthreads();
            if (tid < 384) { const int c2 = tid / 12, r = tid % 12; float s = 0.f; for (int q = 0; q < 16; ++q) s += red[(q * 32 + c2) * 12 + r];
                mod[r * 3072 + 32 * item + c2] = s + b_ada[32 * item + c2]; }
            __syncthreads();
        }
    }
    __syncthreads();
    LAS float* scr = (LAS float*)(L + wave * 16384);
    const int gw = blockIdx.x * 8 + wave, NGW = gridDim.x * 8;
    constexpr int I_IN = 16 * (N_WIN / 32), I_ATT = 16 * 32, I_SSD = 32 * 32, I_OUT = 16 * 32;
    for (int it = gw; it < I_IN + I_ATT + I_SSD + I_OUT; it += NGW) {
        int r = it;
        if (r < I_IN) { const int kb = r / (N_WIN / 32), ng = r % (N_WIN / 32); transpose_item(a.in[11], 1024, N_IN, (bf16_t*)(ws + WS_WIN), 32 * ng, win_src_col(32 * ng), 64 * kb, nullptr, scr, lane); continue; } r -= I_IN;
        if (r < I_ATT) { const int kb = r / 32, ng = r % 32; transpose_item(a.in[15], 1024, 1024, (bf16_t*)(ws + WS_WATT), 32 * ng, gen_src_col(32 * ng), 64 * kb, nullptr, scr, lane); continue; } r -= I_ATT;
        if (r < I_SSD) { const int kb = r / 32, ng = r % 32; transpose_item(a.in[22], 2048, 1024, (bf16_t*)(ws + WS_WSSD), 32 * ng, gen_src_col(32 * ng), 64 * kb, a.in[21], scr, lane); continue; } r -= I_SSD;
        { const int kb = r / 32, ng = r % 32; transpose_item(a.in[23], 1024, 1024, (bf16_t*)(ws + WS_WOUT), 32 * ng, gen_src_col(32 * ng), 64 * kb, nullptr, scr, lane); }
    }
}

__device__ __forceinline__ void phase1() {
    const Args a = kargs();
    const int tid = tid_opaque(), lane = tid & 63, wave = tid >> 6;
    const float* mod = (const float*)(a.ws + WS_MOD); const float* ng = a.in[8];
    bf16_t* H = (bf16_t*)(a.ws + WS_H);
    const int gw = blockIdx.x * 8 + wave, NGW = gridDim.x * 8;
    for (int row = gw; row < M_PAD; row += NGW) {
        u32x2* o8 = (u32x2*)(H + (size_t)row * 1024) + lane;
        if (row >= T_ALL) {
#pragma unroll
            for (int j = 0; j < 4; ++j) o8[64 * j] = (u32x2){0u, 0u};
            continue;
        }
        const float* xr = row < T_P ? a.in[0] + (size_t)row * 1024 : a.in[1] + (size_t)(row - T_P) * 1024;
        const int r12 = row < T_P ? (row >> 13) : 4 + ((row - T_P) >> 4);
        const float* mr = mod + (size_t)r12 * 3072;
        f32x4 v[4]; float s = 0.f;
#pragma unroll
        for (int j = 0; j < 4; ++j) { v[j] = __builtin_nontemporal_load((const f32x4*)xr + lane + 64 * j); s += (v[j][0] * v[j][0] + v[j][1] * v[j][1]) + (v[j][2] * v[j][2] + v[j][3] * v[j][3]); }
#pragma unroll
        for (int o = 1; o < 64; o <<= 1) s += __shfl_xor(s, o);
        const float rinv = rsqrtf(s * (1.f / 1024.f) + EPS);
#pragma unroll
        for (int j = 0; j < 4; ++j) {
            const int c = 4 * (lane + 64 * j);
            const f32x4 gv = *(const f32x4*)(ng + c), sh = *(const f32x4*)(mr + c), scl = *(const f32x4*)(mr + 1024 + c);
            const f32x4 h = v[j] * rinv * gv * (scl + 1.f) + sh;
            o8[64 * j] = (u32x2){cvt_pk_bf16(h[0], h[1]), cvt_pk_bf16(h[2], h[3])};
        }
    }
}

template <bool DUMMY> __device__ __forceinline__ void attn_phase(LAS unsigned char* L) {
    const Args a = kargs();
    const int tid = tid_opaque(), lane = tid & 63, wave = __builtin_amdgcn_readfirstlane(tid >> 6);
    const int r = lane & 15, qq = lane >> 4, hw = wave >> 2, qt = wave & 3;
    bf16_t* Qb = (bf16_t*)(a.ws + WS_Q); const bf16_t* Kb = (const bf16_t*)(a.ws + WS_K); const bf16_t* Vb = (const bf16_t*)(a.ws + WS_V);
    const bf16_t* ZA = (const bf16_t*)(a.ws + WS_ZA);
    const float* cache_k = a.in[4]; const float* cache_v = a.in[5]; const float* rel_bias = a.in[14];
    LAS float* tbl = (LAS float*)(L + 73728);
    constexpr int NPROMPT = NB * 8 * 32, NITEMS = NPROMPT + NSB * 8;
    int tbl_hp = -1;
    for (int id = blockIdx.x; id < NITEMS; id += gridDim.x) {
        const bool samp = id >= NPROMPT;
        int hp, c0, b, sb;
        if (!samp) { hp = id & 7; c0 = 4 * (31 - ((id >> 3) & 31)); b = id >> 8; sb = 0; } else { const int x = id - NPROMPT; hp = x & 7; sb = x >> 3; c0 = 8; b = 0; }
        const int head = 2 * hp + hw;
        if (hp != tbl_hp) {
            for (int i = tid; i < 1280; i += 512) { const int hh = i >= 640 ? 1 : 0, j = i - 640 * hh; int d = j - 63; d = d > 256 ? 256 : d; tbl[i] = rel_bias[(2 * hp + hh) * 513 + d + 256] * LOG2E; }
            tbl_hp = hp;
        }
        const bool wactive = !samp || qt == 0;
        bf16x8 qf[4][2];
#pragma unroll
        for (int cc = 0; cc < 4; ++cc) {
            const int qrow = samp ? T_P + 16 * sb + r : b * SEQ + 64 * (c0 + cc) + 16 * qt + r;
#pragma unroll
            for (int ks = 0; ks < 2; ++ks) qf[cc][ks] = (wactive && (!samp || cc == 0)) ? *(const bf16x8*)(Qb + (size_t)qrow * 1024 + 64 * head + 32 * ks + 8 * qq) : (bf16x8){0, 0, 0, 0, 0, 0, 0, 0};
        }
        const int jlo = samp ? 0 : (c0 >= 8 ? c0 - 8 : 0), jhi = samp ? 8 : c0 + 3;
        u32x4 pre[4];
        auto load_blk = [&](int j) {
            if (tid < 256) {
                const int c16 = tid & 15;
#pragma unroll
                for (int e = 0; e < 4; ++e) { const int key = (tid >> 4) + 16 * e;
                    if (!samp) pre[e] = *(const u32x4*)(Kb + (size_t)(b * SEQ + 64 * j + key) * 1024 + 128 * hp + 8 * c16);
                    else if (j < 8) { const float* s = cache_k + ((size_t)(sb * 512 + 64 * j + key) * 1024 + 128 * hp + 8 * c16); const f32x4 x0 = *(const f32x4*)s, x1 = *(const f32x4*)(s + 4);
                        pre[e] = (u32x4){cvt_pk_bf16(x0[0], x0[1]), cvt_pk_bf16(x0[2], x0[3]), cvt_pk_bf16(x1[0], x1[1]), cvt_pk_bf16(x1[2], x1[3])}; }
                    else pre[e] = key < 16 ? *(const u32x4*)(Kb + (size_t)(T_P + 16 * sb + key) * 1024 + 128 * hp + 8 * c16) : (u32x4){0u, 0u, 0u, 0u}; }
            } else {
                const int u = tid - 256, kg = u >> 4, c16 = u & 15;
#pragma unroll
                for (int e = 0; e < 4; ++e) { const int key = 4 * kg + e;
                    if (!samp) pre[e] = *(const u32x4*)(Vb + (size_t)(b * SEQ + 64 * j + key) * 1024 + 128 * hp + 8 * c16);
                    else if (j < 8) { const float* s = cache_v + ((size_t)(sb * 512 + 64 * j + key) * 1024 + 128 * hp + 8 * c16); const f32x4 x0 = *(const f32x4*)s, x1 = *(const f32x4*)(s + 4);
                        pre[e] = (u32x4){cvt_pk_bf16(x0[0], x0[1]), cvt_pk_bf16(x0[2], x0[3]), cvt_pk_bf16(x1[0], x1[1]), cvt_pk_bf16(x1[2], x1[3])}; }
                    else pre[e] = key < 16 ? *(const u32x4*)(Vb + (size_t)(T_P + 16 * sb + key) * 1024 + 128 * hp + 8 * c16) : (u32x4){0u, 0u, 0u, 0u}; }
            }
        };
        auto write_blk = [&](int buf) {
            if (tid < 256) {
                const int c16 = tid & 15;
#pragma unroll
                for (int e = 0; e < 4; ++e) { const int key = (tid >> 4) + 16 * e; *(LAS u32x4*)(L + buf * 36864 + (c16 >> 3) * 9216 + key * 144 + (c16 & 7) * 16) = pre[e]; }
            } else {
                const int u = tid - 256, kg = u >> 4, c16 = u & 15;
#pragma unroll
                for (int dd = 0; dd < 8; ++dd) { u32x2 w; w.x = pk16(pre[0], pre[1], dd); w.y = pk16(pre[2], pre[3], dd);
                    *(LAS u32x2*)(L + buf * 36864 + 18432 + (c16 >> 3) * 9216 + (8 * (c16 & 7) + dd) * 144 + ((((kg >> 3) * 4 + (kg & 3)) ^ (((c16 & 7) >> 1) | ((c16 >> 3) << 2))) * 16) + ((kg >> 2) & 1) * 8) = w; }
            }
        };
        load_blk(jlo); write_blk(0);
        __syncthreads();
        f32x4 O[4][4]; float m_run[4], lsum[4];
#pragma unroll
        for (int cc = 0; cc < 4; ++cc) { m_run[cc] = -1e30f; lsum[cc] = 0.f;
#pragma unroll
            for (int td = 0; td < 4; ++td) O[cc][td] = (f32x4){0.f, 0.f, 0.f, 0.f}; }
        const LAS float* tblh = tbl + hw * 640;
        const float c256 = tblh[639];
        int cur = 0;
        for (int j = jlo; j <= jhi; ++j) {
            if (j < jhi) load_blk(j + 1);
            if (wactive) {
                const LAS unsigned char* Kl = L + cur * 36864 + hw * 9216; const LAS unsigned char* Vl = L + cur * 36864 + 18432 + hw * 9216;
#pragma unroll
                for (int cc = 0; cc < 4; ++cc) {
                    const int jrel = samp ? j : j - (c0 + cc - 8);
                    if ((samp && cc > 0) || jrel < 0 || jrel > 8) continue;
                    f32x4 st[4];
                    if (jrel <= 3) {
#pragma unroll
                        for (int t = 0; t < 4; ++t) st[t] = (f32x4){c256, c256, c256, c256};
                    } else {
                        const int jb0 = 575 + 16 * qt + r - 64 * jrel - 4 * qq;
#pragma unroll
                        for (int t = 0; t < 4; ++t)
#pragma unroll
                            for (int i = 0; i < 4; ++i) st[t][i] = tblh[jb0 - 16 * t - i];
                    }
#pragma unroll
                    for (int t = 0; t < 4; ++t)
#pragma unroll
                        for (int ks = 0; ks < 2; ++ks) { const bf16x8 kf = *(const LAS bf16x8*)(Kl + (16 * t + r) * 144 + (32 * ks + 8 * qq) * 2); st[t] = mfma16(kf, qf[cc][ks], st[t]); }
                    if (samp && jrel == 8) {
#pragma unroll
                        for (int t = 1; t < 4; ++t) st[t] = (f32x4){-1e30f, -1e30f, -1e30f, -1e30f};
                    }
                    float mx = st[0][0];
#pragma unroll
                    for (int t = 0; t < 4; ++t)
#pragma unroll
                        for (int i = 0; i < 4; ++i) mx = fmaxf(mx, st[t][i]);
                    mx = fmaxf(mx, __shfl_xor(mx, 16)); mx = fmaxf(mx, __shfl_xor(mx, 32));
                    const float m_old = m_run[cc], m_new = mx > m_old + 8.f ? mx : m_old;
                    if (__any(m_new != m_old)) {
                        const float alpha = __builtin_amdgcn_exp2f(m_old - m_new); m_run[cc] = m_new; lsum[cc] *= alpha;
#pragma unroll
                        for (int td = 0; td < 4; ++td) O[cc][td] *= alpha;
                    }
                    float ps = 0.f;
#pragma unroll
                    for (int t = 0; t < 4; ++t)
#pragma unroll
                        for (int i = 0; i < 4; ++i) { st[t][i] = __builtin_amdgcn_exp2f(st[t][i] - m_new); ps += st[t][i]; }
                    lsum[cc] += ps;
                    bf16x8 pf[2];
#pragma unroll
                    for (int kk = 0; kk < 2; ++kk) { u32x4 w; w.x = cvt_pk_bf16(st[2 * kk][0], st[2 * kk][1]); w.y = cvt_pk_bf16(st[2 * kk][2], st[2 * kk][3]);
                        w.z = cvt_pk_bf16(st[2 * kk + 1][0], st[2 * kk + 1][1]); w.w = cvt_pk_bf16(st[2 * kk + 1][2], st[2 * kk + 1][3]); pf[kk] = __builtin_bit_cast(bf16x8, w); }
#pragma unroll
                    for (int td = 0; td < 4; ++td)
#pragma unroll
                        for (int kk = 0; kk < 2; ++kk) { const bf16x8 vf = *(const LAS bf16x8*)(Vl + (16 * td + r) * 144 + (((kk * 4 + qq) ^ (td | (hw << 2))) * 16));
                            O[cc][td] = mfma16(vf, pf[kk], O[cc][td]); }
                }
            }
            if (j < jhi) write_blk(cur ^ 1);
            __syncthreads();
            cur ^= 1;
        }
        if (wactive && (!DUMMY || lsum[0] == 12345.678f)) {
#pragma unroll
            for (int cc = 0; cc < 4; ++cc) {
                if (samp && cc > 0) continue;
                const int qrow = samp ? T_P + 16 * sb + r : b * SEQ + 64 * (c0 + cc) + 16 * qt + r;
                float ls = lsum[cc]; ls += __shfl_xor(ls, 16); ls += __shfl_xor(ls, 32);
                const float inv = 1.f / ls;
#pragma unroll
                for (int td = 0; td < 4; ++td) {
                    const size_t off = (size_t)qrow * 1024 + 64 * head + 16 * td + 4 * qq;
                    const u32x2 zw = *(const u32x2*)(ZA + off);
                    u32x2 w; w.x = cvt_pk_bf16(O[cc][td][0] * inv * bf_lo(zw.x), O[cc][td][1] * inv * bf_hi(zw.x)); w.y = cvt_pk_bf16(O[cc][td][2] * inv * bf_lo(zw.y), O[cc][td][3] * inv * bf_hi(zw.y));
                    *(u32x2*)(Qb + off) = w;
                }
            }
        }
    }
}

__device__ __forceinline__ void conv_phase() {
    const Args a = kargs();
    const int tid = tid_opaque();
    bf16_t* XBC = (bf16_t*)(a.ws + WS_XBC); const bf16_t* HALO = (const bf16_t*)(a.ws + WS_HALO); bf16_t* XBCS = (bf16_t*)(a.ws + WS_XBCS);
    const float* cw = a.in[16]; const float* cb = a.in[17]; const float* st_conv = a.in[6];
    for (int id = blockIdx.x; id < 512 * 6; id += gridDim.x) {
        const int cbk = id % 6, chunk = id / 6, oct = tid & 63, run = tid >> 6, col = 512 * cbk + 8 * oct, row0 = 64 * chunk + 8 * run;
        u32x4 u[11];
#pragma unroll
        for (int i = 0; i < 11; ++i) {
            if (i < 3 && run == 0) u[i] = (chunk & 127) == 0 ? (u32x4){0u, 0u, 0u, 0u} : *(const u32x4*)(HALO + ((size_t)(chunk - 1) * 3 + i) * CONVC + col);
            else u[i] = __builtin_nontemporal_load((const u32x4*)(XBC + (size_t)(row0 - 3 + i) * CONVC + col));
        }
        asm volatile("s_waitcnt vmcnt(0)" ::: "memory");
        __syncthreads();
        float w[4][8], bb[8];
#pragma unroll
        for (int e = 0; e < 8; ++e) { bb[e] = cb[col + e];
#pragma unroll
            for (int j = 0; j < 4; ++j) w[j][e] = cw[j * CONVC + col + e]; }
#pragma unroll
        for (int t = 0; t < 8; ++t) {
            float o[8];
#pragma unroll
            for (int e = 0; e < 8; ++e) {
                float s = bb[e];
#pragma unroll
                for (int j = 0; j < 4; ++j) { const unsigned wd = (e >> 1) == 0 ? u[t + j].x : (e >> 1) == 1 ? u[t + j].y : (e >> 1) == 2 ? u[t + j].z : u[t + j].w; s += w[j][e] * ((e & 1) ? bf_hi(wd) : bf_lo(wd)); }
                o[e] = silu_f(s);
            }
            *(u32x4*)(XBC + (size_t)(row0 + t) * CONVC + col) = pack8(o);
        }
        __syncthreads();
    }
    for (int id = blockIdx.x * 512 + tid; id < T_S * 384; id += gridDim.x * 512) {
        const int oct = id % 384, rr = id / 384, sb = rr >> 4, t = rr & 15, col = 8 * oct;
        float o[8];
#pragma unroll
        for (int e = 0; e < 8; ++e) o[e] = cb[col + e];
#pragma unroll
        for (int j = 0; j < 4; ++j) {
            const int tt = t - 3 + j; float xv[8];
            if (tt >= 0) { const u32x4 q = *(const u32x4*)(XBC + (size_t)(T_P + 16 * sb + tt) * CONVC + col);
                xv[0] = bf_lo(q.x); xv[1] = bf_hi(q.x); xv[2] = bf_lo(q.y); xv[3] = bf_hi(q.y); xv[4] = bf_lo(q.z); xv[5] = bf_hi(q.z); xv[6] = bf_lo(q.w); xv[7] = bf_hi(q.w); }
            else { const float* s = st_conv + ((size_t)(sb * 3 + (tt + 3)) * CONVC + col);
#pragma unroll
                for (int e = 0; e < 8; ++e) xv[e] = s[e]; }
#pragma unroll
            for (int e = 0; e < 8; ++e) o[e] += cw[j * CONVC + col + e] * xv[e];
        }
#pragma unroll
        for (int e = 0; e < 8; ++e) o[e] = silu_f(o[e]);
        *(u32x4*)(XBCS + (size_t)rr * CONVC + col) = pack8(o);
    }
}

constexpr int SC_CS = 0, SC_BS = 17408, SC_BT = 34816, SC_XT = 53248, SC_LS = 62464, SC_HS = 71680, SC_XS = 89088, SC_ZS = 98304, SC_YS = 107520,
              SC_ACS = 116736, SC_WLS = 116992, SC_DTS = 117248, SC_SSL = 117504;
template <bool DUMMY> __device__ __forceinline__ void scan_phase(LAS unsigned char* L) {
    const Args a = kargs();
    const int tid = tid_opaque(), lane = tid & 63, wave = __builtin_amdgcn_readfirstlane(tid >> 6);
    const int r = lane & 15, qq = lane >> 4;
    const bf16_t* XBC = (const bf16_t*)(a.ws + WS_XBC); bf16_t* ZS = (bf16_t*)(a.ws + WS_ZS); const float* DT = (const float*)(a.ws + WS_DT);
    float* ssqp = (float*)(a.ws + WS_SSQP); float* ssqs = (float*)(a.ws + WS_SSQS);
    const float* a_log = a.in[19]; const float* d_skip = a.in[20];
    bf16_t* Y1 = (bf16_t*)(a.ws + WS_H); float* SST0 = (float*)(a.ws + WS_SST0); float* SST1 = (float*)(a.ws + WS_SST1); float* ACUM = (float*)(a.ws + WS_ACUM); float* ATOT = (float*)(a.ws + WS_ATOT);
    for (int id = blockIdx.x; id < NB * 32 * 2; id += gridDim.x) {
        const int combo = (id & 7) * 4 + (id >> 6), seg = combo & 1, g = (combo >> 1) & 3, b = combo >> 3, h = g * 8 + ((id >> 3) & 7), ck0 = 64 * seg;
        float arun = 0.f;
        const float a_h = -__expf(a_log[h]), dsk = d_skip[h];
        f32x4 Hacc[4];
#pragma unroll
        for (int t2 = 0; t2 < 4; ++t2) Hacc[t2] = (f32x4){0.f, 0.f, 0.f, 0.f};
        for (int i = tid; i < 17408 / 4; i += 512) *(LAS unsigned*)(L + SC_HS + 4 * i) = 0u;
        u32x4 pre[8]; float dtv = 0.f;
        const int xcol = 64 * h;
        auto load_ck = [&](int ck) {
            const size_t rowbase = (size_t)b * SEQ + 64 * ck;
            if (tid < 256) { const int u = tid & 127, rg = u >> 4, c = u & 15; const int col = (tid < 128 ? 2048 : 2560) + 128 * g + 8 * c;
#pragma unroll
                for (int e = 0; e < 8; ++e) pre[e] = *(const u32x4*)(XBC + (rowbase + 8 * rg + e) * CONVC + col);
            } else if (tid < 320) { const int u = tid - 256, rg = u >> 3, c = u & 7;
#pragma unroll
                for (int e = 0; e < 8; ++e) pre[e] = *(const u32x4*)(XBC + (rowbase + 8 * rg + e) * CONVC + xcol + 8 * c);
            } else if (tid < 384) { const int u = tid - 320, rg = u >> 3, c = u & 7;
#pragma unroll
                for (int e = 0; e < 8; ++e) pre[e] = *(const u32x4*)(ZS + (rowbase + 8 * rg + e) * SSDW + xcol + 8 * c);
            } else if (tid >= 448) dtv = DT[(rowbase + lane) * 32 + h];
        };
        int wck = ck0;
        auto write_ck = [&]() {
            if (tid < 256) { const int u = tid & 127, rg = u >> 4, c = u & 15; const int base = tid < 128 ? SC_BS : SC_CS;
#pragma unroll
                for (int e = 0; e < 8; ++e) *(LAS u32x4*)(L + base + (8 * rg + e) * 272 + c * 16) = pre[e];
                if (tid < 128) {
#pragma unroll
                    for (int dd = 0; dd < 8; ++dd) { u32x4 w; w.x = pk16(pre[0], pre[1], dd); w.y = pk16(pre[2], pre[3], dd); w.z = pk16(pre[4], pre[5], dd); w.w = pk16(pre[6], pre[7], dd);
                        *(LAS u32x4*)(L + SC_BT + (8 * c + dd) * 144 + ((rg ^ (c >> 1)) * 16)) = w; }
                }
            } else if (tid < 320) { const int u = tid - 256, rg = u >> 3, c = u & 7;
#pragma unroll
                for (int e = 0; e < 8; ++e) *(LAS u32x4*)(L + SC_XS + (8 * rg + e) * 144 + c * 16) = pre[e];
#pragma unroll
                for (int dd = 0; dd < 8; ++dd) { u32x4 w; w.x = pk16(pre[0], pre[1], dd); w.y = pk16(pre[2], pre[3], dd); w.z = pk16(pre[4], pre[5], dd); w.w = pk16(pre[6], pre[7], dd);
                    *(LAS u32x4*)(L + SC_XT + (8 * c + dd) * 144 + ((rg ^ (c >> 1)) * 16)) = w; }
            } else if (tid < 384) { const int u = tid - 320, rg = u >> 3, c = u & 7;
#pragma unroll
                for (int e = 0; e < 8; ++e) *(LAS u32x4*)(L + SC_ZS + (8 * rg + e) * 144 + c * 16) = pre[e];
            } else if (tid >= 448) {
                float x = dtv * a_h;
#pragma unroll
                for (int o = 1; o < 64; o <<= 1) { const float y = __shfl_up(x, o); if (lane >= o) x += y; }
                const float tot = __shfl(x, 63);
                if (seg == 1) ACUM[(size_t)(b * 32 + h) * 4096 + 64 * (wck - 64) + lane] = arun + x;
                arun += tot;
                ((LAS float*)(L + SC_ACS))[lane] = x; ((LAS float*)(L + SC_WLS))[lane] = dtv * __expf(tot - x); ((LAS float*)(L + SC_DTS))[lane] = dtv;
            }
        };
        load_ck(ck0);
        const int tl = wave >> 1, tpb = 2 * (wave & 1);
        for (int ck = ck0; ck < ck0 + 64; ++ck) {
            const size_t rowbase = (size_t)b * SEQ + 64 * ck;
            wck = ck;
            write_ck();
            if (ck + 1 < ck0 + 64) load_ck(ck + 1);
            __syncthreads();
            {
#pragma unroll
                for (int tsi = 0; tsi < 2; ++tsi) {
                    const int ts = tpb + tsi; const int l = 16 * tl + r;
                    u32x2 w = (u32x2){0u, 0u};
                    if (ts <= tl) {
                        f32x4 cbv = (f32x4){0.f, 0.f, 0.f, 0.f};
#pragma unroll
                        for (int ks = 0; ks < 4; ++ks) { const bf16x8 af = *(const LAS bf16x8*)(L + SC_BS + (16 * ts + r) * 272 + (32 * ks + 8 * qq) * 2);
                            const bf16x8 bf = *(const LAS bf16x8*)(L + SC_CS + (16 * tl + r) * 272 + (32 * ks + 8 * qq) * 2); cbv = mfma16(af, bf, cbv); }
                        const float al = ((const LAS float*)(L + SC_ACS))[l];
                        const f32x4 as4 = *(const LAS f32x4*)(L + SC_ACS + (16 * ts + 4 * qq) * 4), dt4 = *(const LAS f32x4*)(L + SC_DTS + (16 * ts + 4 * qq) * 4);
                        float v[4];
#pragma unroll
                        for (int i = 0; i < 4; ++i) { const int s = 16 * ts + 4 * qq + i; const float d = fminf(al - as4[i], 0.f); v[i] = s <= l ? cbv[i] * __expf(d) * dt4[i] : 0.f; }
                        w.x = cvt_pk_bf16(v[0], v[1]); w.y = cvt_pk_bf16(v[2], v[3]);
                    }
                    *(LAS u32x2*)(L + SC_LS + l * 144 + (16 * ts + 4 * qq) * 2) = w;
                }
            }
            f32x4 yst[2]; yst[0] = (f32x4){0.f, 0.f, 0.f, 0.f}; yst[1] = (f32x4){0.f, 0.f, 0.f, 0.f};
#pragma unroll
            for (int ks = 0; ks < 4; ++ks) { const bf16x8 bf = *(const LAS bf16x8*)(L + SC_CS + (16 * tl + r) * 272 + (32 * ks + 8 * qq) * 2);
#pragma unroll
                for (int tpi = 0; tpi < 2; ++tpi) { const bf16x8 af = *(const LAS bf16x8*)(L + SC_HS + (16 * (tpb + tpi) + r) * 272 + (32 * ks + 8 * qq) * 2); yst[tpi] = mfma16(af, bf, yst[tpi]); } }
            __syncthreads();
            {
                f32x4 yin[2]; yin[0] = (f32x4){0.f, 0.f, 0.f, 0.f}; yin[1] = (f32x4){0.f, 0.f, 0.f, 0.f};
#pragma unroll
                for (int ks = 0; ks < 2; ++ks) { const bf16x8 bf = *(const LAS bf16x8*)(L + SC_LS + (16 * tl + r) * 144 + (32 * ks + 8 * qq) * 2);
#pragma unroll
                    for (int tpi = 0; tpi < 2; ++tpi) { const bf16x8 af = *(const LAS bf16x8*)(L + SC_XT + (16 * (tpb + tpi) + r) * 144 + (((4 * ks + qq) ^ (tpb + tpi)) * 16)); yin[tpi] = mfma16(af, bf, yin[tpi]); } }
                const int l = 16 * tl + r;
                const float el = __expf(((const LAS float*)(L + SC_ACS))[l]);
                float ss = 0.f;
#pragma unroll
                for (int tpi = 0; tpi < 2; ++tpi) {
                    const int po = (16 * (tpb + tpi) + 4 * qq) * 2;
                    const u32x2 xw = *(const LAS u32x2*)(L + SC_XS + l * 144 + po), zw = *(const LAS u32x2*)(L + SC_ZS + l * 144 + po);
                    const float xv[4] = {bf_lo(xw.x), bf_hi(xw.x), bf_lo(xw.y), bf_hi(xw.y)}, zv[4] = {bf_lo(zw.x), bf_hi(zw.x), bf_lo(zw.y), bf_hi(zw.y)};
                    float gy[4];
#pragma unroll
                    for (int i = 0; i < 4; ++i) { gy[i] = (yin[tpi][i] + el * yst[tpi][i] + dsk * xv[i]) * zv[i]; ss += gy[i] * gy[i]; }
                    *(LAS u32x2*)(L + SC_YS + l * 144 + po) = (u32x2){cvt_pk_bf16(gy[0], gy[1]), cvt_pk_bf16(gy[2], gy[3])};
                }
                ss += __shfl_xor(ss, 16); ss += __shfl_xor(ss, 32);
                if (qq == 0) ((LAS float*)(L + SC_SSL))[(wave & 1) * 64 + l] = ss;
                const float E = __expf(((const LAS float*)(L + SC_ACS))[63]);
                const int t2 = wave & 3, nb = 4 * (wave >> 2);
                bf16x8 xsc[2];
#pragma unroll
                for (int ks = 0; ks < 2; ++ks) {
                    const u32x4 raw = *(const LAS u32x4*)(L + SC_XT + (16 * t2 + r) * 144 + (((4 * ks + qq) ^ t2) * 16));
                    const f32x4 w0 = *(const LAS f32x4*)(L + SC_WLS + (32 * ks + 8 * qq) * 4), w1 = *(const LAS f32x4*)(L + SC_WLS + (32 * ks + 8 * qq + 4) * 4);
                    u32x4 sc; sc.x = cvt_pk_bf16(bf_lo(raw.x) * w0[0], bf_hi(raw.x) * w0[1]); sc.y = cvt_pk_bf16(bf_lo(raw.y) * w0[2], bf_hi(raw.y) * w0[3]);
                    sc.z = cvt_pk_bf16(bf_lo(raw.z) * w1[0], bf_hi(raw.z) * w1[1]); sc.w = cvt_pk_bf16(bf_lo(raw.w) * w1[2], bf_hi(raw.w) * w1[3]);
                    xsc[ks] = __builtin_bit_cast(bf16x8, sc);
                }
#pragma unroll
                for (int j = 0; j < 4; ++j) {
                    Hacc[j] *= E;
#pragma unroll
                    for (int ks = 0; ks < 2; ++ks) { const bf16x8 bfr = *(const LAS bf16x8*)(L + SC_BT + (16 * (nb + j) + r) * 144 + (((4 * ks + qq) ^ ((nb + j) & 7)) * 16)); Hacc[j] = mfma16(bfr, xsc[ks], Hacc[j]); }
                    *(LAS u32x2*)(L + SC_HS + (16 * t2 + r) * 272 + (16 * (nb + j) + 4 * qq) * 2) = (u32x2){cvt_pk_bf16(Hacc[j][0], Hacc[j][1]), cvt_pk_bf16(Hacc[j][2], Hacc[j][3])};
                }
            }
            __syncthreads();
            if (!DUMMY) { const int row = tid >> 3, c = tid & 7; const u32x4 v = *(const LAS u32x4*)(L + SC_YS + row * 144 + c * 16);
              if (seg == 0) *(u32x4*)(ZS + (rowbase + row) * SSDW + xcol + 8 * c) = v;
              else *(u32x4*)(Y1 + ((size_t)b * 4096 + 64 * (ck - 64) + row) * SSDW + xcol + 8 * c) = v; }
            if (!DUMMY && seg == 0 && tid < 64) { const float v = ((const LAS float*)(L + SC_SSL))[tid] + ((const LAS float*)(L + SC_SSL))[64 + tid];
                ssqp[(size_t)(g * 8 + (h & 7)) * T_P + rowbase + tid] = v; }
        }
#pragma unroll
        for (int j = 0; j < 4; ++j) *(f32x4*)((seg == 0 ? SST0 : SST1) + ((size_t)((b * 32 + h) * 64 + 16 * (wave & 3) + r)) * 128 + 16 * (4 * (wave >> 2) + j) + 4 * qq) = Hacc[j];
        if (seg == 1 && tid == 448) ATOT[b * 32 + h] = arun;
        __syncthreads();
    }
    {
        const bf16_t* XBCS = (const bf16_t*)(a.ws + WS_XBCS); const float* st_ssm = a.in[7];
        LAS float* xs = (LAS float*)L;
        LAS float* Bv = xs + 1024;
        LAS float* Cv = Bv + 2048;
        LAS float* acs = Cv + 2048;
        LAS float* dtl = acs + 16;
        LAS float* Lm = dtl + 16;
        LAS float* wl16 = Lm + 256;
        LAS float* hst = wl16 + 16;
        const int G = gridDim.x;
        const int s0 = (int)blockIdx.x, sstep = G;
        for (int id = DUMMY ? NSB * 32 : s0; id < NSB * 32; id += sstep) {
            const int h = id & 31, sb = id >> 5, g = h >> 3;
            const float a_h = -__expf(a_log[h]), dsk = d_skip[h];
            __syncthreads();
            _Pragma("clang loop unroll(disable) vectorize(disable)") for (int i = tid; i < 1024; i += 512) { const int t = i >> 6, p = i & 63; xs[i] = __uint_as_float((unsigned)XBCS[(size_t)(16 * sb + t) * CONVC + 64 * h + p] << 16); }
            _Pragma("clang loop unroll(disable) vectorize(disable)") for (int i = tid; i < 2048; i += 512) { const int t = i >> 7, n = i & 127; Bv[i] = __uint_as_float((unsigned)XBCS[(size_t)(16 * sb + t) * CONVC + 2048 + 128 * g + n] << 16);
                Cv[i] = __uint_as_float((unsigned)XBCS[(size_t)(16 * sb + t) * CONVC + 2560 + 128 * g + n] << 16); }
            _Pragma("clang loop unroll(disable) vectorize(disable)") for (int i = tid; i < 8192; i += 512) { const int p = i >> 7, n = i & 127; hst[p * 129 + n] = st_ssm[((size_t)(sb * 32 + h) * 64 + p) * 128 + n]; }
            if (tid == 0) { float c = 0.f; for (int t = 0; t < 16; ++t) { const float d = DT[(size_t)(T_P + 16 * sb + t) * 32 + h]; c += d * a_h; acs[t] = c; dtl[t] = d; }
                for (int t = 0; t < 16; ++t) wl16[t] = dtl[t] * __expf(c - acs[t]); }
            __syncthreads();
            if (tid < 256) { const int l = tid >> 4, s = tid & 15; float v = 0.f;
                if (s <= l) { float dsum = 0.f; _Pragma("clang loop unroll_count(4)") for (int n = 0; n < 128; ++n) dsum += Cv[l * 128 + n] * Bv[s * 128 + n]; v = dsum * __expf(acs[l] - acs[s]) * dtl[s]; }
                Lm[tid] = v; }
            __syncthreads();
            _Pragma("clang loop unroll(disable) vectorize(disable)") for (int j = 0; j < 2; ++j) {
                const int i = tid + 512 * j, l = i >> 6, p = i & 63;
                float y = 0.f;
                _Pragma("clang loop unroll(disable) vectorize(disable)") for (int s = 0; s <= l; ++s) y += Lm[l * 16 + s] * xs[s * 64 + p];
                float ys = 0.f;
                _Pragma("clang loop unroll_count(4)") for (int n = 0; n < 128; ++n) ys += Cv[l * 128 + n] * hst[p * 129 + n];
                y += __expf(acs[l]) * ys + dsk * xs[l * 64 + p];
                const size_t off = (size_t)(T_P + 16 * sb + l) * SSDW + 64 * h + p;
                const float gy = y * __uint_as_float((unsigned)ZS[off] << 16);
                float ss = gy * gy;
#pragma unroll
                for (int o = 1; o < 64; o <<= 1) ss += __shfl_xor(ss, o);
                if (lane == 0) ssqs[(size_t)(sb * 32 + h) * 32 + l] = ss;
                ZS[off] = (bf16_t)(cvt_pk_bf16(gy, 0.f) & 0xffffu);
            }
            const float E = __expf(acs[15]);
            _Pragma("clang loop unroll(disable) vectorize(disable)") for (int j = 0; j < 16; ++j) {
                const int i = tid + 512 * j, p = i >> 7, n = i & 127;
                float v = hst[p * 129 + n] * E;
                _Pragma("clang loop unroll(disable) vectorize(disable)") for (int l = 0; l < 16; ++l) v += Bv[l * 128 + n] * xs[l * 64 + p] * wl16[l];
                a.out[O_HS + ((size_t)(sb * 32 + h) * 64 + p) * 128 + n] = v;
            }
        }
        __syncthreads();
    }
}

template <bool DUMMY> __device__ __forceinline__ void scanfix_phase(LAS unsigned char* L) {
    const Args a = kargs();
    const int tid = tid_opaque(), lane = tid & 63, wave = __builtin_amdgcn_readfirstlane(tid >> 6);
    const int r = lane & 15, qq = lane >> 4;
    const bf16_t* XBC = (const bf16_t*)(a.ws + WS_XBC); bf16_t* ZS = (bf16_t*)(a.ws + WS_ZS); const bf16_t* Y1 = (const bf16_t*)(a.ws + WS_H);
    const float* SST0 = (const float*)(a.ws + WS_SST0); const float* SST1 = (const float*)(a.ws + WS_SST1); const float* ACUM = (const float*)(a.ws + WS_ACUM); const float* ATOT = (const float*)(a.ws + WS_ATOT);
    float* ssqp = (float*)(a.ws + WS_SSQP);
    constexpr int FX_HS = 0, FX_CS = 17408, FX_SSL = 34816;
    for (int id = blockIdx.x; id < NB * 32 * 2; id += gridDim.x) {
        const int combo = (id & 7) * 4 + (id >> 6), half = combo & 1, g = (combo >> 1) & 3, b = combo >> 3, h = g * 8 + ((id >> 3) & 7), bh = b * 32 + h;
        __syncthreads();
        const float eA = __expf(ATOT[bh]);
#pragma unroll
        for (int j = 0; j < 4; ++j) {
            const int e4 = tid + 512 * j, p = e4 >> 5, n = (e4 & 31) * 4;
            const f32x4 s0 = *(const f32x4*)(SST0 + ((size_t)bh * 64 + p) * 128 + n);
            *(LAS u32x2*)(L + FX_HS + p * 272 + n * 2) = (u32x2){cvt_pk_bf16(s0[0], s0[1]), cvt_pk_bf16(s0[2], s0[3])};
            if (!DUMMY && half == 0) { const f32x4 s1 = *(const f32x4*)(SST1 + ((size_t)bh * 64 + p) * 128 + n); *(f32x4*)(a.out + O_HP + ((size_t)bh * 64 + p) * 128 + n) = s1 + s0 * eA; }
        }
        const int tl = wave >> 1, tpb = 2 * (wave & 1);
        u32x4 cpre[2];
        { const size_t rb0 = (size_t)b * SEQ + 64 * (64 + 32 * half);
#pragma unroll
          for (int j = 0; j < 2; ++j) { const int e = tid + 512 * j, row = e >> 4, c = e & 15; cpre[j] = *(const u32x4*)(XBC + (rb0 + row) * CONVC + 2560 + 128 * g + 8 * c); } }
        for (int cki = 0; cki < 32; ++cki) {
            const int ck = 64 + 32 * half + cki;
            const size_t rowbase = (size_t)b * SEQ + 64 * ck, y1base = (size_t)b * 4096 + 64 * (ck - 64);
#pragma unroll
            for (int j = 0; j < 2; ++j) { const int e = tid + 512 * j, row = e >> 4, c = e & 15; *(LAS u32x4*)(L + FX_CS + row * 272 + c * 16) = cpre[j]; }
            __syncthreads();
            if (cki + 1 < 32) {
#pragma unroll
                for (int j = 0; j < 2; ++j) { const int e = tid + 512 * j, row = e >> 4, c = e & 15; cpre[j] = *(const u32x4*)(XBC + (rowbase + 64 + row) * CONVC + 2560 + 128 * g + 8 * c); }
            }
            const int l = 16 * tl + r;
            const float acv = ACUM[(size_t)bh * 4096 + 64 * (ck - 64) + l];
            u32x2 yw[2], zw[2];
#pragma unroll
            for (int tpi = 0; tpi < 2; ++tpi) { const int col = 64 * h + 16 * (tpb + tpi) + 4 * qq;
                yw[tpi] = *(const u32x2*)(Y1 + (y1base + l) * SSDW + col); zw[tpi] = *(const u32x2*)(ZS + (rowbase + l) * SSDW + col); }
            f32x4 yf[2]; yf[0] = (f32x4){0.f, 0.f, 0.f, 0.f}; yf[1] = (f32x4){0.f, 0.f, 0.f, 0.f};
#pragma unroll
            for (int ks = 0; ks < 4; ++ks) { const bf16x8 bf = *(const LAS bf16x8*)(L + FX_CS + (16 * tl + r) * 272 + (32 * ks + 8 * qq) * 2);
#pragma unroll
                for (int tpi = 0; tpi < 2; ++tpi) { const bf16x8 af = *(const LAS bf16x8*)(L + FX_HS + (16 * (tpb + tpi) + r) * 272 + (32 * ks + 8 * qq) * 2); yf[tpi] = mfma16(af, bf, yf[tpi]); } }
            const float el = __expf(acv);
            float ss = 0.f;
#pragma unroll
            for (int tpi = 0; tpi < 2; ++tpi) {
                const int col = 64 * h + 16 * (tpb + tpi) + 4 * qq;
                float gy[4];
                gy[0] = bf_lo(yw[tpi].x) + el * yf[tpi][0] * bf_lo(zw[tpi].x); gy[1] = bf_hi(yw[tpi].x) + el * yf[tpi][1] * bf_hi(zw[tpi].x);
                gy[2] = bf_lo(yw[tpi].y) + el * yf[tpi][2] * bf_lo(zw[tpi].y); gy[3] = bf_hi(yw[tpi].y) + el * yf[tpi][3] * bf_hi(zw[tpi].y);
#pragma unroll
                for (int i = 0; i < 4; ++i) ss += gy[i] * gy[i];
                if (!DUMMY || ss == 12345.678f) *(u32x2*)(ZS + (rowbase + l) * SSDW + col) = (u32x2){cvt_pk_bf16(gy[0], gy[1]), cvt_pk_bf16(gy[2], gy[3])};
            }
            ss += __shfl_xor(ss, 16); ss += __shfl_xor(ss, 32);
            if (qq == 0) ((LAS float*)(L + FX_SSL))[(wave & 1) * 64 + l] = ss;
            __syncthreads();
            if (!DUMMY && tid < 64) ssqp[(size_t)h * T_P + rowbase + tid] = ((const LAS float*)(L + FX_SSL))[tid] + ((const LAS float*)(L + FX_SSL))[64 + tid];
        }
    }
}

__device__ __forceinline__ void ynorm_phase() {
    const Args a = kargs();
    const int tid = tid_opaque(), lane = tid & 63, wave = tid >> 6;
    bf16_t* Y = (bf16_t*)(a.ws + WS_ZS); const float* ssqp = (const float*)(a.ws + WS_SSQP); const float* ssqs = (const float*)(a.ws + WS_SSQS);
    const int gw = blockIdx.x * 8 + wave, NGW = gridDim.x * 8;
    for (int row = gw; row < T_ALL; row += NGW) {
        float sv = 0.f;
        if (lane < 32) sv = row < T_P ? ssqp[(size_t)lane * T_P + row] : ssqs[(size_t)(((row - T_P) >> 4) * 32 + lane) * 32 + ((row - T_P) & 15)];
        sv += __shfl_xor(sv, 1); sv += __shfl_xor(sv, 2); sv += __shfl_xor(sv, 4);
        const float s4[4] = {__shfl(sv, 0), __shfl(sv, 8), __shfl(sv, 16), __shfl(sv, 24)};
        u32x4* p = (u32x4*)(Y + (size_t)row * SSDW) + lane;
#pragma unroll
        for (int j = 0; j < 4; ++j) {
            const float rinv = rsqrtf(s4[j] * (1.f / 512.f) + EPS);
            const u32x4 v = __builtin_nontemporal_load(p + 64 * j);
            u32x4 o; o.x = cvt_pk_bf16(bf_lo(v.x) * rinv, bf_hi(v.x) * rinv); o.y = cvt_pk_bf16(bf_lo(v.y) * rinv, bf_hi(v.y) * rinv);
            o.z = cvt_pk_bf16(bf_lo(v.z) * rinv, bf_hi(v.z) * rinv); o.w = cvt_pk_bf16(bf_lo(v.w) * rinv, bf_hi(v.w) * rinv);
            p[64 * j] = o;
        }
    }
}

template <int MODE>
__device__ __forceinline__ void mini_gemm(const bf16_t* A, const bf16_t* Bt, int K, bf16_t* Mo, const unsigned char* gates, float* out, const float* xs, const float* mod) {
    const int tid = tid_opaque(), lane = tid & 63, wave = __builtin_amdgcn_readfirstlane(tid >> 6), r = lane & 15, qq = lane >> 4;
    for (int t = blockIdx.x; t < 64; t += gridDim.x) {
        const int n0 = 16 * t, jj = n0 & 255;
        const int prow = (n0 & ~255) + 128 * ((jj >> 5) & 1) + 32 * (jj >> 6) + (jj & 31);
        const bf16_t* ap = A + (size_t)(T_P + 16 * wave + r) * K + 8 * qq;
        const bf16_t* bp = Bt + (size_t)(prow + r) * K + 8 * qq;
        f32x4 acc = (f32x4){0.f, 0.f, 0.f, 0.f};
#pragma unroll 8
        for (int k = 0; k < K; k += 32) { const bf16x8 af = *(const bf16x8*)(ap + k), bf = *(const bf16x8*)(bp + k); acc = mfma16(bf, af, acc); }
        const int row = T_P + 16 * wave + r, col = n0 + 4 * qq;
        if (MODE == 0) {
            const u32x2 gw = *(const u32x2*)(gates + (size_t)row * 4096 + (size_t)col * 2);
            *(u32x2*)(Mo + (size_t)row * 1024 + col) = (u32x2){cvt_pk_bf16(bf_lo(gw.x) * acc[0], bf_hi(gw.x) * acc[1]), cvt_pk_bf16(bf_lo(gw.y) * acc[2], bf_hi(gw.y) * acc[3])};
        } else if (MODE == 1) {
            const u32x2 gw = *(const u32x2*)(gates + (size_t)row * 4096 + (size_t)(1024 + col) * 2); const u32x2 mw = *(const u32x2*)(Mo + (size_t)row * 1024 + col);
            *(u32x2*)(Mo + (size_t)row * 1024 + col) = (u32x2){cvt_pk_bf16(bf_lo(mw.x) + bf_lo(gw.x) * acc[0], bf_hi(mw.x) + bf_hi(gw.x) * acc[1]), cvt_pk_bf16(bf_lo(mw.y) + bf_lo(gw.y) * acc[2], bf_hi(mw.y) + bf_hi(gw.y) * acc[3])};
        } else {
            const int r12 = 4 + ((row - T_P) >> 4);
            const f32x4 xv = *(const f32x4*)(xs + (size_t)(row - T_P) * 1024 + col), gv = *(const f32x4*)(mod + (size_t)r12 * 3072 + 2048 + col);
            *(f32x4*)(out + (size_t)row * 1024 + col) = xv + gv * acc;
        }
    }
}

#define XB_TMO      128
#define XB_XCNT(j)  (256  + 64 * (j))
#define XB_XSUB(j)  (1280 + 64 * (j))
#define XB_XGEN(j)  (2304 + 64 * (j))
#define XB_TOP      3328
#define XB_TOPGEN   3392
#define XCD_BAR_WORDS 3456
#define XB_SPIN_CAP (1u << 18)

__device__ __forceinline__ unsigned xb_ld(unsigned* p)              { return __hip_atomic_load(p, __ATOMIC_RELAXED, __HIP_MEMORY_SCOPE_AGENT); }
__device__ __forceinline__ unsigned xb_add(unsigned* p, unsigned v) { return __hip_atomic_fetch_add(p, v, __ATOMIC_RELAXED, __HIP_MEMORY_SCOPE_AGENT); }
__device__ __forceinline__ unsigned xb_xcc_id() { return (unsigned)__builtin_amdgcn_s_getreg((3 << 11) | 20) & 0xFu; }
#define XB_SPIN(cond, bar) do { unsigned _sp = 0; while (cond) { __builtin_amdgcn_s_sleep(1); \
    if ((++_sp & 255u) == 0u) { if (xb_ld(&(bar)[XB_TMO])) break; if (_sp > XB_SPIN_CAP) { atomicAdd(&(bar)[XB_TMO], 1u); break; } } } } while (0)

struct XcdBarrier {
    unsigned* bar; unsigned x;
    volatile LAS unsigned* st;
};

__device__ __forceinline__ XcdBarrier xcd_barrier_post(unsigned* bar, volatile LAS unsigned* st) {
    XcdBarrier b; b.bar = bar; b.x = xb_xcc_id(); b.st = st;
    if (threadIdx.x == 0) (void)xb_add(&bar[XB_XCNT(b.x)], 1u);
    return b;
}
__device__ __forceinline__ void xcd_barrier_complete(unsigned* bar, unsigned x, unsigned& nloc, unsigned& nx) {
    const unsigned G = gridDim.x * gridDim.y * gridDim.z;
    unsigned sum, cnt, mine, sp = 0u;
    for (;;) {
        sum = 0u; cnt = 0u; mine = 0u;
#pragma unroll
        for (unsigned j = 0; j < 16; ++j) { const unsigned c = xb_ld(&bar[XB_XCNT(j)]); sum += c; cnt += (c > 0u) ? 1u : 0u; mine = (j == x) ? c : mine; }
        if (sum == G) break;
        __builtin_amdgcn_s_sleep(1);
        if ((++sp & 255u) == 0u) { if (xb_ld(&bar[XB_TMO])) break; if (sp > XB_SPIN_CAP) { atomicAdd(&bar[XB_TMO], 1u); break; } }
    }
    nloc = mine > 0u ? mine : 1u; nx = cnt > 0u ? cnt : 1u;
}

__device__ __forceinline__ void xcd_barrier(const XcdBarrier& b) {
    asm volatile("s_waitcnt vmcnt(0)" ::: "memory");
    __syncthreads();
    if (threadIdx.x == 0) {
        unsigned* bar = b.bar;
        __builtin_amdgcn_s_waitcnt(0);
        unsigned nloc = b.st[0], nx = b.st[1];
        if (nloc == 0u) { xcd_barrier_complete(bar, b.x, nloc, nx); b.st[0] = nloc; b.st[1] = nx; }
        const unsigned old = xb_add(&bar[XB_XSUB(b.x)], 1u);
        const unsigned gen = old / nloc;
        if (old + 1u == (gen + 1u) * nloc) {
            __builtin_amdgcn_fence(__ATOMIC_RELEASE, "agent");
            asm volatile("s_waitcnt vmcnt(0)" ::: "memory");
            const unsigned og = xb_add(&bar[XB_TOP], 1u);
            const unsigned tg = og / nx;
            if (og + 1u == (tg + 1u) * nx) xb_add(&bar[XB_TOPGEN], 1u);
            else XB_SPIN(xb_ld(&bar[XB_TOPGEN]) == tg, bar);
            __builtin_amdgcn_fence(__ATOMIC_ACQUIRE, "agent");
            xb_add(&bar[XB_XGEN(b.x)], 1u);
            asm volatile("s_waitcnt vmcnt(0)" ::: "memory");
        } else {
            XB_SPIN(xb_ld(&bar[XB_XGEN(b.x)]) == gen, bar);
            __builtin_amdgcn_fence(__ATOMIC_ACQUIRE, "agent");
            asm volatile("s_waitcnt vmcnt(0)" ::: "memory");
        }
    }
    __syncthreads();
}


constexpr size_t WS_BAR = 200 * 1024;
__device__ __forceinline__ void grid_barrier(unsigned* bar, unsigned& gen) {
    asm volatile("s_waitcnt vmcnt(0) lgkmcnt(0)" ::: "memory");
    __syncthreads();
    ++gen;
    if (threadIdx.x == 0) {
        __builtin_amdgcn_fence(__ATOMIC_RELEASE, "agent");
        asm volatile("s_waitcnt vmcnt(0)" ::: "memory");
        const unsigned target = gen * gridDim.x;
        __hip_atomic_fetch_add(bar, 1u, __ATOMIC_RELAXED, __HIP_MEMORY_SCOPE_AGENT);
        while (__hip_atomic_load(bar, __ATOMIC_RELAXED, __HIP_MEMORY_SCOPE_AGENT) < target) __builtin_amdgcn_s_sleep(1);
        __builtin_amdgcn_fence(__ATOMIC_ACQUIRE, "agent");
        asm volatile("s_waitcnt vmcnt(0)" ::: "memory");
    }
    __syncthreads();
}

__global__ void __launch_bounds__(512, 2) fwd_megakernel(Args a_in) {
    extern __shared__ __attribute__((aligned(16))) unsigned char lds_raw[];
    LAS unsigned char* L = (LAS unsigned char*)lds_raw;
    cg::grid_group grid = cg::this_grid();
    const int G = gridDim.x, c = blockIdx.x;
    if (gridDim.y == 0x7fffu) grid.sync();
    unsigned* bar; { const Args a = kargs(); bar = (unsigned*)(a.ws + WS_BAR); }
    unsigned gen = 0; (void)gen;
    volatile LAS unsigned* xst = (volatile LAS unsigned*)(L + LDS_BYTES - 64);
    if (threadIdx.x == 0) { xst[0] = 0u; xst[1] = 0u; }
    __syncthreads();
    const XcdBarrier xbar = xcd_barrier_post(bar, xst);
#define GRID_SYNC() xcd_barrier(xbar)

    phase0(L);
#if defined(DUP_P01)
    GRID_SYNC();
    phase1();
    GRID_SYNC();
    phase0(L);
#endif
    GRID_SYNC();
#if defined(STOP_AFTER)
    if (STOP_AFTER == 1) return;
#endif
    phase1();
    GRID_SYNC();
#if defined(STOP_AFTER)
    if (STOP_AFTER == 2) return;
#endif
    {
        const Args a = kargs(); unsigned char* ws = a.ws;
        pg8::Gemm g{(const bf16_t*)(ws + WS_H), (const bf16_t*)(ws + WS_WIN), M_PAD, NT1 * 256, 1024}; pg8::StaticOrder S; S.init(M_PAD, NT1 * 256, G, c);
        EpiIn1 E{(bf16_t*)(ws + WS_Q), (bf16_t*)(ws + WS_K), (bf16_t*)(ws + WS_V), (bf16_t*)(ws + WS_ZA), (unsigned char*)a.out, a.out, a.in[12], a.in[13]};
        pg8::gemm_phase<EpiIn1, pg8::StaticOrder, true, true>(L, g, S, E);
#if defined(DUP_P2)
        __syncthreads();
        pg8::gemm_phase<EpiIn1, pg8::StaticOrder, true, true>(L, g, S, E);
#endif
    }
    GRID_SYNC();
#if defined(STOP_AFTER)
    if (STOP_AFTER == 3) return;
#endif
#if defined(DUP_ATTN)
    attn_phase<true>(L);
#endif
    attn_phase<false>(L);
    GRID_SYNC();
#if defined(STOP_AFTER)
    if (STOP_AFTER == 4) return;
#endif
    {
        const Args a = kargs(); unsigned char* ws = a.ws;
        pg8::Gemm g{(const bf16_t*)(ws + WS_H), (const bf16_t*)(ws + WS_WIN) + (size_t)NT1 * 256 * 1024, M_PAD, NT2 * 256, 1024}; pg8::StaticOrder S; S.init(M_PAD, NT2 * 256, G, c);
        EpiIn2 E{(bf16_t*)(ws + WS_ZS), (bf16_t*)(ws + WS_XBC), (bf16_t*)(ws + WS_HALO), (float*)(ws + WS_DT), a.out, a.in[18]};
        pg8::gemm_phase<EpiIn2, pg8::StaticOrder, true, true>(L, g, S, E);
#if defined(DUP_P4)
        __syncthreads();
        pg8::gemm_phase<EpiIn2, pg8::StaticOrder, true, true>(L, g, S, E);
#endif
    }
    GRID_SYNC();
#if defined(STOP_AFTER)
    if (STOP_AFTER == 5) return;
#endif
    conv_phase();
    GRID_SYNC();
#if defined(STOP_AFTER)
    if (STOP_AFTER == 6) return;
#endif
#if defined(DUP_SCAN)
    scan_phase<true>(L);
#endif
    scan_phase<false>(L);
    GRID_SYNC();
#if defined(DUP_FIX)
    scanfix_phase<true>(L);
#endif
    scanfix_phase<false>(L);
    GRID_SYNC();
#if defined(STOP_AFTER)
    if (STOP_AFTER == 7) return;
#endif
    ynorm_phase();
    {
        const Args a = kargs(); unsigned char* ws = a.ws;
        pg8::Gemm g{(const bf16_t*)(ws + WS_Q), (const bf16_t*)(ws + WS_WATT), T_P, 1024, 1024}; pg8::StaticOrder S; S.init(T_P, 1024, G, c);
        EpiA E{(bf16_t*)(ws + WS_H), (const unsigned char*)a.out};
        pg8::gemm_phase<EpiA, pg8::StaticOrder, true, true>(L, g, S, E);
        mini_gemm<0>((const bf16_t*)(ws + WS_Q), (const bf16_t*)(ws + WS_WATT), 1024, (bf16_t*)(ws + WS_H), (const unsigned char*)a.out, nullptr, nullptr, nullptr);
    }
    GRID_SYNC();
#if defined(STOP_AFTER)
    if (STOP_AFTER == 8) return;
#endif
    {
        const Args a = kargs(); unsigned char* ws = a.ws;
        pg8::Gemm g{(const bf16_t*)(ws + WS_ZS), (const bf16_t*)(ws + WS_WSSD), T_P, 1024, 2048}; pg8::StaticOrder S; S.init(T_P, 1024, G, c);
        EpiB E{(bf16_t*)(ws + WS_H), (const unsigned char*)a.out};
        pg8::gemm_phase<EpiB, pg8::StaticOrder, true, true>(L, g, S, E);
        mini_gemm<1>((const bf16_t*)(ws + WS_ZS), (const bf16_t*)(ws + WS_WSSD), 2048, (bf16_t*)(ws + WS_H), (const unsigned char*)a.out, nullptr, nullptr, nullptr);
    }
    GRID_SYNC();
#if defined(STOP_AFTER)
    if (STOP_AFTER == 9) return;
#endif
    {
        const Args a = kargs(); unsigned char* ws = a.ws;
        pg8::Gemm g{(const bf16_t*)(ws + WS_H), (const bf16_t*)(ws + WS_WOUT), T_P, 1024, 1024}; pg8::StaticOrder S; S.init(T_P, 1024, G, c);
        EpiOut E{a.out, a.in[0], a.in[1], (const float*)(ws + WS_MOD)};
        pg8::gemm_phase<EpiOut, pg8::StaticOrder, true, true>(L, g, S, E);
        mini_gemm<2>((const bf16_t*)(ws + WS_H), (const bf16_t*)(ws + WS_WOUT), 1024, nullptr, nullptr, a.out, a.in[1], (const float*)(ws + WS_MOD));
    }
}

extern "C" void kernel_launch(void* const* d_in, const int* in_sizes, int n_in, void* d_out, int out_size, void* d_ws, size_t ws_size, hipStream_t stream) {
    static int grid = 0;
    if (grid == 0) {
        if (n_in != 24 || (size_t)out_size != O_END || ws_size < WS_END) { fprintf(stderr, "kernel_launch: unexpected shapes (n_in %d out %d ws %zu)\n", n_in, out_size, ws_size); grid = -1; return; }
        int dev = 0, cus = 0, per_cu = 0;
        hipGetDevice(&dev); hipDeviceGetAttribute(&cus, hipDeviceAttributeMultiprocessorCount, dev);
        if (hipFuncSetAttribute((const void*)fwd_megakernel, hipFuncAttributeMaxDynamicSharedMemorySize, LDS_BYTES) != hipSuccess) { fprintf(stderr, "kernel_launch: hipFuncSetAttribute failed\n"); grid = -1; return; }
        if (hipOccupancyMaxActiveBlocksPerMultiprocessor(&per_cu, (const void*)fwd_megakernel, 512, LDS_BYTES) != hipSuccess || per_cu < 1) per_cu = 1;
        (void)hipGetLastError();
        grid = cus * per_cu;
    }
    if (grid < 0) return;
    if (hipMemsetAsync((char*)d_ws + WS_BAR, 0, 16384, stream) != hipSuccess) { fprintf(stderr, "kernel_launch: memset failed\n"); return; }
    Args a{};
    for (int i = 0; i < 24; ++i) a.in[i] = (const float*)d_in[i];
    a.out = (float*)d_out; a.ws = (unsigned char*)d_ws;
    void* args[] = {&a};
    hipError_t e = hipLaunchCooperativeKernel((const void*)fwd_megakernel, dim3(grid), dim3(512), args, LDS_BYTES, stream);
    if (e != hipSuccess) fprintf(stderr, "cooperative launch failed: %s (grid %d)\n", hipGetErrorString(e), grid);
}
```

```cpp
#include <hip/hip_runtime.h>
#include <hip/hip_cooperative_groups.h>
#include <cstdio>
#include <cstdint>
namespace cg = cooperative_groups;

#define LAS __attribute__((address_space(3)))
typedef unsigned short bf16_t;
typedef short bf16x8 __attribute__((ext_vector_type(8)));
typedef float f32x4 __attribute__((ext_vector_type(4)));
typedef float f32x2 __attribute__((ext_vector_type(2)));
typedef unsigned u32x4 __attribute__((ext_vector_type(4)));
typedef unsigned u32x2 __attribute__((ext_vector_type(2)));

constexpr int DM = 1024, T_P = 32768, T_S = 128, T_ALL = T_P + T_S, M_PAD = 33024;
constexpr int SEQ = 8192, NB = 4, NSB = 8, TS = 16;
constexpr int N_IN = 11296, NT1 = 24, NT2 = 21, N_WIN = (NT1 + NT2) * 256;
constexpr int CONVC = 3072, SSDW = 2048;
constexpr float EPS = 1e-6f, LOG2E = 1.4426950408889634f, QSCALE = 0.125f * 1.4426950408889634f;
constexpr size_t O_YP = 0, O_YS = O_YP + (size_t)T_P * DM, O_KP = O_YS + (size_t)T_S * DM, O_VP = O_KP + (size_t)NB * 512 * 1024,
                 O_CP = O_VP + (size_t)NB * 512 * 1024, O_HP = O_CP + (size_t)NB * 3 * CONVC, O_KS = O_HP + (size_t)NB * 32 * 64 * 128,
                 O_VS = O_KS + (size_t)T_S * 1024, O_CS = O_VS + (size_t)T_S * 1024, O_HS = O_CS + (size_t)NSB * 3 * CONVC,
                 O_END = O_HS + (size_t)NSB * 32 * 64 * 128;
constexpr size_t MiB = 1u << 20;
constexpr size_t WS_MOD = 0, WS_SSQ = 256 * 1024, WS_WIN = 1 * MiB, WS_WATT = 24 * MiB, WS_WSSD = 26 * MiB, WS_WOUT = 30 * MiB,
                 WS_HALO = 32 * MiB, WS_XBCS = 42 * MiB, WS_H = 43 * MiB, ROWB = (size_t)M_PAD * 1024 * 2  ,
                 WS_Q = WS_H + ROWB, WS_R = WS_Q + ROWB, WS_K = WS_R, WS_V = WS_R + ROWB, WS_ZA = WS_R + 2 * ROWB, WS_XBC = WS_R,
                 WS_ZS = WS_R + 3 * ROWB, WS_DT = WS_ZS + 2 * ROWB, WS_SSQP = WS_DT + (size_t)M_PAD * 32 * 4  , WS_SSQS = WS_SSQP + (size_t)32 * T_P * 4  , WS_END = WS_SSQS + (size_t)NSB * 32 * 32 * 4;
constexpr size_t WS_SST0 = WS_HALO, WS_SST1 = WS_HALO + 4 * MiB, WS_ACUM = WS_HALO + 8 * MiB, WS_ATOT = WS_SSQ;
static_assert(WS_END <= 512 * MiB, "workspace map");
static_assert(WS_SSQ + (size_t)T_ALL * 16 <= WS_WIN && WS_WIN + (size_t)N_WIN * 1024 * 2 <= WS_WATT, "ws map");
constexpr int LDS_BYTES = 147456;

typedef __bf16 bf16x2_t __attribute__((ext_vector_type(2)));
__device__ __forceinline__ unsigned cvt_pk_bf16(float lo, float hi) { const f32x2 v = {lo, hi}; const bf16x2_t b = __builtin_convertvector(v, bf16x2_t); return __builtin_bit_cast(unsigned, b); }
__device__ __forceinline__ void store16_wt(void* p, u32x4 v) { asm volatile("global_store_dwordx4 %0, %1, off sc0 sc1" :: "v"(p), "v"(v) : "memory"); }
__device__ __forceinline__ int tid_opaque() { int t = threadIdx.x; asm volatile("" : "+v"(t)); return t; }
__device__ __forceinline__ float bf_lo(unsigned w) { return __uint_as_float(w << 16); }
__device__ __forceinline__ float bf_hi(unsigned w) { return __uint_as_float(w & 0xffff0000u); }
__device__ __forceinline__ float silu_f(float x) { return x * __builtin_amdgcn_rcpf(1.f + __expf(-x)); }
__device__ __forceinline__ float sigmoid_f(float x) { return __builtin_amdgcn_rcpf(1.f + __expf(-x)); }
__device__ __forceinline__ f32x4 mfma16(bf16x8 a, bf16x8 b, f32x4 c) { return __builtin_amdgcn_mfma_f32_16x16x32_bf16(a, b, c, 0, 0, 0); }
__device__ __forceinline__ u32x4 pack8(const float* v) { u32x4 w; w.x = cvt_pk_bf16(v[0], v[1]); w.y = cvt_pk_bf16(v[2], v[3]); w.z = cvt_pk_bf16(v[4], v[5]); w.w = cvt_pk_bf16(v[6], v[7]); return w; }
__device__ __forceinline__ unsigned pk16(const u32x4& a, const u32x4& b, int dd) {
    const unsigned wa = (dd >> 1) == 0 ? a.x : (dd >> 1) == 1 ? a.y : (dd >> 1) == 2 ? a.z : a.w, wb = (dd >> 1) == 0 ? b.x : (dd >> 1) == 1 ? b.y : (dd >> 1) == 2 ? b.z : b.w;
    return (dd & 1) ? __builtin_amdgcn_perm(wb, wa, 0x07060302u) : __builtin_amdgcn_perm(wb, wa, 0x05040100u);
}
__device__ __forceinline__ unsigned el16(const u32x4& v, int dd) { const unsigned w = (dd >> 1) == 0 ? v.x : (dd >> 1) == 1 ? v.y : (dd >> 1) == 2 ? v.z : v.w; return (dd & 1) ? (w >> 16) : (w & 0xffffu); }

namespace pg8 {
#define PG8_LAS __attribute__((address_space(3)))
constexpr int BM = 256, BK = 64, HALF = 128, HTB = HALF * BK * 2, STAGE_BYTES = 8 * HTB, NXCD = 8, WGM = 8;
__host__ __device__ __forceinline__ int lds_byte(int r, int c) { const int st = (r >> 4) * 2 + (c >> 5), rr = r & 15, cc = c & 31, ob = rr * 64 + cc * 2; return st * 1024 + (ob ^ (((ob >> 9) & 1) << 5)); }
__host__ __device__ __forceinline__ void stage_rc(int b, int& R, int& C) { const int st = b / 1024, sb = b % 1024, swz = sb ^ (((sb >> 9) & 1) << 5); R = (st >> 1) * 16 + swz / 64; C = (st & 1) * 32 + (swz % 64) / 2; }
__host__ __device__ __forceinline__ int perm32(int rho) { const int n = rho >> 4, i = rho & 15; return 8 * (i >> 2) + 4 * n + (i & 3); }
struct Unit { int pm, pn; };
struct Gemm { const bf16_t* A; const bf16_t* Bt; int M, N, K; };
struct StaticOrder {
    int nM, nN, nwg, G, c;
    __host__ __device__ void init(int M, int N, int G_, int c_) { nM = M / BM; nN = N / BM; nwg = nM * nN; G = G_; c = c_; }
    __host__ __device__ bool next(int i, Unit& u) const {
        const long L = (long)i * G + c; if (L >= nwg) return false;
        int wgid = (int)L; { const int q = nwg / NXCD, r = nwg % NXCD, xcd = wgid % NXCD, off = wgid / NXCD; wgid = (xcd < r ? xcd * (q + 1) : r * (q + 1) + (xcd - r) * q) + off; }
        const int nig = WGM * nN, gid = wgid / nig, fm = gid * WGM, gsz = (nM - fm) < WGM ? (nM - fm) : WGM;
        u.pm = fm + ((wgid % nig) % gsz); u.pn = (wgid % nig) / gsz; return true;
    }
    __device__ __forceinline__ void a_ready(const Unit&) const {}
    __device__ __forceinline__ void done(const Unit&) const {}
};
template <class Epi, class Sched, bool ALIGN_EPI = false, bool SP2 = false>
__device__ __forceinline__ void gemm_phase(PG8_LAS unsigned char* lds, const Gemm g, const Sched& S, const Epi& E) {
    int tid_ = threadIdx.x; asm volatile("" : "+v"(tid_));
    const int tid = tid_, wid = __builtin_amdgcn_readfirstlane(tid >> 6), lane = tid & 63, wr = wid >> 2, wc = wid & 3, fr = lane & 15, fq = lane >> 4;
    const int K = g.K, nt = K / BK;
    unsigned voffA[2], voffB[2];
#pragma unroll
    for (int i = 0; i < 2; ++i) { int R, C; stage_rc(tid * 16 + i * 8192, R, C); const int Rb = Epi::PERM ? ((R & ~31) + perm32(R & 31)) : R;
        voffA[i] = (unsigned)(R * K + C) * 2u; voffB[i] = (unsigned)(Rb * K + C) * 2u; }
    const size_t kstep = (size_t)(BK * 2);
    const size_t hstep = (size_t)HALF * K * 2;
    const size_t tstep = 2 * hstep;
    const unsigned ldsw = (unsigned)wid * 1024u;
    const int aoff = lds_byte(wr * 64 + fr, fq * 8), boff = lds_byte(wc * 32 + fr, fq * 8);
#define PG8_SA(b, h) (((b) * 2 + (h)) * HTB)
#define PG8_SB(b, h) ((4 + (b) * 2 + (h)) * HTB)
#define PG8_STAGE(bufoff, gbase, voff) do { _Pragma("unroll") for (int _i = 0; _i < 2; ++_i) \
        __builtin_amdgcn_global_load_lds((const unsigned*)((const char*)(gbase) + (voff)[_i]), (PG8_LAS unsigned*)(lds + (bufoff) + ldsw + _i * 8192), 16, 0, 0); } while (0)
#define PG8_LDA(dst, b, h) do { _Pragma("unroll") for (int m = 0; m < 4; ++m) _Pragma("unroll") for (int k = 0; k < 2; ++k) dst[m][k] = *(const PG8_LAS bf16x8*)(lds + PG8_SA(b, h) + aoff + m * 2048 + k * 1024); } while (0)
#define PG8_LDB(dst, b, h) do { _Pragma("unroll") for (int n = 0; n < 2; ++n) _Pragma("unroll") for (int k = 0; k < 2; ++k) dst[n][k] = *(const PG8_LAS bf16x8*)(lds + PG8_SB(b, h) + boff + n * 2048 + k * 1024); } while (0)
#define PG8_MMA(ai, bj, At, Bt) do { __builtin_amdgcn_s_setprio(1); _Pragma("unroll") for (int m = 0; m < 4; ++m) _Pragma("unroll") for (int n = 0; n < 2; ++n) _Pragma("unroll") for (int k = 0; k < 2; ++k) \
        acc[ai][bj][m][n] = __builtin_amdgcn_mfma_f32_16x16x32_bf16(Bt[n][k], At[m][k], acc[ai][bj][m][n], 0, 0, 0); __builtin_amdgcn_s_setprio(0); } while (0)
#define PG8_WAIT_V(n) asm volatile("s_waitcnt vmcnt(" #n ")" ::: "memory")
#define PG8_WAIT_L(n) asm volatile("s_waitcnt lgkmcnt(" #n ")" ::: "memory")
#define PG8_BAR __builtin_amdgcn_s_barrier()
#define PG8_SCHED __builtin_amdgcn_sched_barrier(0)
    Unit cur, nxt; int ui = 0;
    if (!S.next(0, cur)) return;
    f32x4 acc[2][2][4][2];
#pragma unroll
    for (int a = 0; a < 2; ++a)
#pragma unroll
        for (int b = 0; b < 2; ++b)
#pragma unroll
            for (int m = 0; m < 4; ++m)
#pragma unroll
                for (int n = 0; n < 2; ++n) acc[a][b][m][n] = (f32x4){0.f, 0.f, 0.f, 0.f};
    bf16x8 At[4][2], B0[2][2], B1[2][2];
    const char* cA = (const char*)g.A + (size_t)cur.pm * tstep; const char* cB = (const char*)g.Bt + (size_t)cur.pn * tstep;
    S.a_ready(cur);
    if constexpr (SP2) {
        PG8_STAGE(PG8_SB(0, 0), cB, voffB); PG8_STAGE(PG8_SB(0, 1), cB + hstep, voffB); PG8_STAGE(PG8_SA(0, 0), cA, voffA); PG8_STAGE(PG8_SA(0, 1), cA + hstep, voffA);
        if (wr == 1) PG8_BAR;
        PG8_WAIT_V(2); PG8_BAR;
        PG8_STAGE(PG8_SB(1, 0), cB + kstep, voffB); PG8_STAGE(PG8_SA(1, 0), cA + kstep, voffA); PG8_STAGE(PG8_SB(1, 1), cB + hstep + kstep, voffB);
        PG8_WAIT_V(6); PG8_BAR;
    } else {
        PG8_STAGE(PG8_SB(0, 0), cB, voffB); PG8_STAGE(PG8_SA(0, 0), cA, voffA); PG8_STAGE(PG8_SB(0, 1), cB + hstep, voffB); PG8_STAGE(PG8_SA(0, 1), cA + hstep, voffA);
        if (wr == 1) PG8_BAR;
        PG8_WAIT_V(4); PG8_BAR;
        PG8_STAGE(PG8_SB(1, 0), cB + kstep, voffB); PG8_STAGE(PG8_SA(1, 0), cA + kstep, voffA); PG8_STAGE(PG8_SB(1, 1), cB + hstep + kstep, voffB);
        PG8_WAIT_V(6); PG8_BAR;
    }
    for (;;) {
        const bool has_next = S.next(ui + 1, nxt);
        const char* nA = has_next ? (const char*)g.A + (size_t)nxt.pm * tstep : cA; const char* nB = has_next ? (const char*)g.Bt + (size_t)nxt.pn * tstep : cB;
        for (int t = 0; t < nt; t += 2) {
            const bool last = (t == nt - 2);
            const char* a1 = cA + (size_t)(t + 1) * kstep;
            const char* a2 = last ? nA : cA + (size_t)(t + 2) * kstep; const char* b2 = last ? nB : cB + (size_t)(t + 2) * kstep;
            const char* a3 = a2 + kstep; const char* b3 = b2 + kstep;
            if (last && has_next) S.a_ready(nxt);
            if constexpr (SP2) {
            PG8_LDB(B0, 0, 0); PG8_LDB(B1, 0, 1); PG8_SCHED; PG8_LDA(At, 0, 0); PG8_STAGE(PG8_SA(1, 1), a1 + hstep, voffA);
            PG8_WAIT_V(8); PG8_WAIT_L(0); PG8_BAR; PG8_MMA(0, 0, At, B0); PG8_MMA(0, 1, At, B1); PG8_BAR; PG8_SCHED;
            PG8_LDA(At, 0, 1); PG8_STAGE(PG8_SB(0, 0), b2, voffB); PG8_STAGE(PG8_SB(0, 1), b2 + hstep, voffB); PG8_STAGE(PG8_SA(0, 0), a2, voffA);
            PG8_WAIT_V(8); PG8_WAIT_L(0); PG8_BAR; PG8_MMA(1, 0, At, B0); PG8_MMA(1, 1, At, B1); PG8_BAR; PG8_SCHED;
            PG8_LDB(B0, 1, 0); PG8_LDB(B1, 1, 1); PG8_SCHED; PG8_LDA(At, 1, 0); PG8_STAGE(PG8_SA(0, 1), a2 + hstep, voffA);
            PG8_WAIT_V(8); PG8_WAIT_L(0); PG8_BAR; PG8_MMA(0, 0, At, B0); PG8_MMA(0, 1, At, B1); PG8_BAR; PG8_SCHED;
            PG8_LDA(At, 1, 1); PG8_STAGE(PG8_SB(1, 0), b3, voffB); PG8_STAGE(PG8_SB(1, 1), b3 + hstep, voffB); PG8_STAGE(PG8_SA(1, 0), a3, voffA);
            PG8_WAIT_V(8); PG8_WAIT_L(0); PG8_BAR; PG8_MMA(1, 0, At, B0); PG8_MMA(1, 1, At, B1); PG8_BAR; PG8_SCHED;
            } else {
            PG8_LDB(B0, 0, 0); PG8_SCHED; PG8_LDA(At, 0, 0); PG8_STAGE(PG8_SA(1, 1), a1 + hstep, voffA);
            PG8_WAIT_L(8); PG8_BAR; PG8_WAIT_L(0); PG8_MMA(0, 0, At, B0); PG8_BAR; PG8_SCHED;
            PG8_LDB(B1, 0, 1); PG8_STAGE(PG8_SB(0, 0), b2, voffB);
            PG8_BAR; PG8_WAIT_L(0); PG8_MMA(0, 1, At, B1); PG8_BAR;
            PG8_LDA(At, 0, 1); PG8_STAGE(PG8_SA(0, 0), a2, voffA);
            PG8_BAR; PG8_WAIT_L(0); PG8_MMA(1, 0, At, B0); PG8_BAR; PG8_SCHED;
            PG8_STAGE(PG8_SB(0, 1), b2 + hstep, voffB);
            PG8_WAIT_V(6); PG8_BAR; PG8_MMA(1, 1, At, B1); PG8_BAR;
            PG8_LDB(B0, 1, 0); PG8_SCHED; PG8_LDA(At, 1, 0); PG8_STAGE(PG8_SA(0, 1), a2 + hstep, voffA);
            PG8_WAIT_L(8); PG8_BAR; PG8_WAIT_L(0); PG8_MMA(0, 0, At, B0); PG8_BAR; PG8_SCHED;
            PG8_LDB(B1, 1, 1); PG8_STAGE(PG8_SB(1, 0), b3, voffB);
            PG8_BAR; PG8_WAIT_L(0); PG8_MMA(0, 1, At, B1); PG8_BAR;
            PG8_LDA(At, 1, 1); PG8_STAGE(PG8_SA(1, 0), a3, voffA);
            PG8_BAR; PG8_WAIT_L(0); PG8_MMA(1, 0, At, B0); PG8_BAR; PG8_SCHED;
            PG8_STAGE(PG8_SB(1, 1), b3 + hstep, voffB);
            PG8_WAIT_V(6); PG8_BAR; PG8_MMA(1, 1, At, B1); PG8_BAR;
            }
        }
        if constexpr (ALIGN_EPI) { if (wr == 0) PG8_BAR; }
        E(acc, cur, wr, wc, fr, fq); S.done(cur);
        if (!has_next) break;
#pragma unroll
        for (int a = 0; a < 2; ++a)
#pragma unroll
            for (int b = 0; b < 2; ++b)
#pragma unroll
                for (int m = 0; m < 4; ++m)
#pragma unroll
                    for (int n = 0; n < 2; ++n) acc[a][b][m][n] = (f32x4){0.f, 0.f, 0.f, 0.f};
        cur = nxt; cA = nA; cB = nB; ++ui;
        if constexpr (ALIGN_EPI) { if (wr == 1) PG8_BAR; }
    }
    PG8_WAIT_V(0);
    if constexpr (!ALIGN_EPI) { if (wr == 0) PG8_BAR; }
    PG8_BAR;
#undef PG8_SA
#undef PG8_SB
#undef PG8_STAGE
#undef PG8_LDA
#undef PG8_LDB
#undef PG8_MMA
#undef PG8_WAIT_V
#undef PG8_WAIT_L
#undef PG8_BAR
#undef PG8_SCHED
}
}
using pg8::Unit;

#define EPI_ROW(u, ai, wr, m, fr) ((u).pm * 256 + (ai) * 128 + (wr) * 64 + (m) * 16 + (fr))

struct EpiIn1 {
    static constexpr bool PERM = true, AFTER_DRAIN = false;
    bf16_t *Q, *K, *V, *ZA; unsigned char* gates; float* out; const float *qg, *kg;
    __device__ __forceinline__ void operator()(const f32x4 (&acc)[2][2][4][2], const Unit& u, int wr, int wc, int fr, int fq) const {
        const int pn = u.pn, seg = pn >> 2;
        if (seg <= 1) {
            const float* gv = seg == 0 ? qg : kg; const float sc = seg == 0 ? QSCALE : 1.f;
            float g[2][8];
#pragma unroll
            for (int bj = 0; bj < 2; ++bj)
#pragma unroll
                for (int e = 0; e < 8; ++e) g[bj][e] = gv[32 * bj + 8 * fq + e] * sc;
            const int colbase = (pn & 3) * 256 + 64 * wc + 8 * fq;
            bf16_t* dstb = seg == 0 ? Q : K;
#pragma unroll
            for (int ai = 0; ai < 2; ++ai)
#pragma unroll
                for (int m = 0; m < 4; ++m) {
                    float ss = 0.f;
#pragma unroll
                    for (int bj = 0; bj < 2; ++bj)
#pragma unroll
                        for (int n = 0; n < 2; ++n) { const f32x4 v = acc[ai][bj][m][n]; ss += (v[0] * v[0] + v[1] * v[1]) + (v[2] * v[2] + v[3] * v[3]); }
                    ss += __shfl_xor(ss, 16); ss += __shfl_xor(ss, 32);
                    const float rinv = rsqrtf(ss * (1.f / 64.f) + EPS);
                    const int row = EPI_ROW(u, ai, wr, m, fr);
#pragma unroll
                    for (int bj = 0; bj < 2; ++bj) {
                        float o[8];
#pragma unroll
                        for (int e = 0; e < 8; ++e) o[e] = acc[ai][bj][m][e >> 2][e & 3] * rinv * g[bj][e];
                        const int col = colbase + 32 * bj;
                        *(u32x4*)(dstb + (size_t)row * 1024 + col) = pack8(o);
                        if (seg == 1) {
                            float* d = nullptr;
                            if (row < T_P) { const int s = row & (SEQ - 1); if (s >= SEQ - 512) d = out + O_KP + ((size_t)((row >> 13) * 512 + s - (SEQ - 512)) * 1024 + col); }
                            else if (row < T_ALL) d = out + O_KS + ((size_t)(row - T_P) * 1024 + col);
                            if (d) { *(f32x4*)d = (f32x4){o[0], o[1], o[2], o[3]}; *(f32x4*)(d + 4) = (f32x4){o[4], o[5], o[6], o[7]}; }
                        }
                    }
                }
        } else if (seg <= 3) {
            const int colbase = (pn & 3) * 256 + 64 * wc + 8 * fq;
            bf16_t* dstb = seg == 2 ? V : ZA;
#pragma unroll
            for (int ai = 0; ai < 2; ++ai)
#pragma unroll
                for (int m = 0; m < 4; ++m) {
                    const int row = EPI_ROW(u, ai, wr, m, fr);
#pragma unroll
                    for (int bj = 0; bj < 2; ++bj) {
                        float o[8];
#pragma unroll
                        for (int e = 0; e < 8; ++e) { const float v = acc[ai][bj][m][e >> 2][e & 3]; o[e] = seg == 2 ? v : silu_f(v); }
                        const int col = colbase + 32 * bj;
                        *(u32x4*)(dstb + (size_t)row * 1024 + col) = pack8(o);
                        if (seg == 2) {
                            float* d = nullptr;
                            if (row < T_P) { const int s = row & (SEQ - 1); if (s >= SEQ - 512) d = out + O_VP + ((size_t)((row >> 13) * 512 + s - (SEQ - 512)) * 1024 + col); }
                            else if (row < T_ALL) d = out + O_VS + ((size_t)(row - T_P) * 1024 + col);
                            if (d) { *(f32x4*)d = (f32x4){o[0], o[1], o[2], o[3]}; *(f32x4*)(d + 4) = (f32x4){o[4], o[5], o[6], o[7]}; }
                        }
                    }
                }
        } else {
            const int colbase = (pn - 16) * 256 + 64 * wc + 8 * fq;
#pragma unroll
            for (int ai = 0; ai < 2; ++ai)
#pragma unroll
                for (int m = 0; m < 4; ++m) {
                    const int row = EPI_ROW(u, ai, wr, m, fr);
                    if (row < T_ALL) {
#pragma unroll
                        for (int bj = 0; bj < 2; ++bj) {
                            float o[8];
#pragma unroll
                            for (int e = 0; e < 8; ++e) o[e] = sigmoid_f(acc[ai][bj][m][e >> 2][e & 3]);
                            *(u32x4*)(gates + (size_t)row * 4096 + (size_t)(colbase + 32 * bj) * 2) = pack8(o);
                        }
                    }
                }
        }
    }
};

struct EpiIn2 {
    static constexpr bool PERM = true, AFTER_DRAIN = false;
    bf16_t *ZS, *XBC, *HALO; float* DT; float* out; const float* dt_bias;
    __device__ __forceinline__ void operator()(const f32x4 (&acc)[2][2][4][2], const Unit& u, int wr, int wc, int fr, int fq) const {
        const int pn = u.pn;
        if (pn < 8) {
            const int colbase = pn * 256 + 64 * wc + 8 * fq;
#pragma unroll
            for (int ai = 0; ai < 2; ++ai)
#pragma unroll
                for (int m = 0; m < 4; ++m) {
                    const int row = EPI_ROW(u, ai, wr, m, fr);
#pragma unroll
                    for (int bj = 0; bj < 2; ++bj) {
                        float o[8];
#pragma unroll
                        for (int e = 0; e < 8; ++e) o[e] = silu_f(acc[ai][bj][m][e >> 2][e & 3]);
                        *(u32x4*)(ZS + (size_t)row * SSDW + colbase + 32 * bj) = pack8(o);
                    }
                }
        } else if (pn < 20) {
            const int colbase = (pn - 8) * 256 + 64 * wc + 8 * fq;
#pragma unroll
            for (int ai = 0; ai < 2; ++ai)
#pragma unroll
                for (int m = 0; m < 4; ++m) {
                    const int row = EPI_ROW(u, ai, wr, m, fr);
#pragma unroll
                    for (int bj = 0; bj < 2; ++bj) {
                        float o[8];
#pragma unroll
                        for (int e = 0; e < 8; ++e) o[e] = acc[ai][bj][m][e >> 2][e & 3];
                        const int col = colbase + 32 * bj;
                        const u32x4 w = pack8(o);
                        *(u32x4*)(XBC + (size_t)row * CONVC + col) = w;
                        if (m == 3 && fr >= 13) {
                            *(u32x4*)(HALO + ((size_t)(row >> 6) * 3 + (fr - 13)) * CONVC + col) = w;
                            if (row < T_P && (row & (SEQ - 1)) >= SEQ - 3) {
                                float* d = out + O_CP + ((size_t)((row >> 13) * 3 + (fr - 13)) * CONVC + col);
                                *(f32x4*)d = (f32x4){o[0], o[1], o[2], o[3]}; *(f32x4*)(d + 4) = (f32x4){o[4], o[5], o[6], o[7]};
                            }
                        }
                        if (fr >= 13 && row >= T_P && row < T_ALL) {
                            float* d = out + O_CS + ((size_t)(((row - T_P) >> 4) * 3 + (fr - 13)) * CONVC + col);
                            *(f32x4*)d = (f32x4){o[0], o[1], o[2], o[3]}; *(f32x4*)(d + 4) = (f32x4){o[4], o[5], o[6], o[7]};
                        }
                    }
                }
        } else {
            if (wc == 0) {
                float bb[8];
#pragma unroll
                for (int e = 0; e < 8; ++e) bb[e] = dt_bias[8 * fq + e];
#pragma unroll
                for (int ai = 0; ai < 2; ++ai)
#pragma unroll
                    for (int m = 0; m < 4; ++m) {
                        const int row = EPI_ROW(u, ai, wr, m, fr);
                        float o[8];
#pragma unroll
                        for (int e = 0; e < 8; ++e) { const float v = acc[ai][0][m][e >> 2][e & 3] + bb[e]; o[e] = v > 20.f ? v : log1pf(__expf(v)); }
                        float* d = DT + (size_t)row * 32 + 8 * fq;
                        *(f32x4*)d = (f32x4){o[0], o[1], o[2], o[3]}; *(f32x4*)(d + 4) = (f32x4){o[4], o[5], o[6], o[7]};
                    }
            }
        }
    }
};

struct EpiA {
    static constexpr bool PERM = true, AFTER_DRAIN = false;
    bf16_t* Mo; const unsigned char* gates;
    __device__ __forceinline__ void operator()(const f32x4 (&acc)[2][2][4][2], const Unit& u, int wr, int wc, int fr, int fq) const {
        const int colbase = u.pn * 256 + 64 * wc + 8 * fq;
#pragma unroll
        for (int ai = 0; ai < 2; ++ai)
#pragma unroll
            for (int m = 0; m < 4; ++m) {
                const int row = EPI_ROW(u, ai, wr, m, fr);
#pragma unroll
                for (int bj = 0; bj < 2; ++bj) {
                    const int col = colbase + 32 * bj;
                    u32x4 gw = (u32x4){0u, 0u, 0u, 0u};
                    if (row < T_ALL) gw = *(const u32x4*)(gates + (size_t)row * 4096 + (size_t)col * 2);
                    const unsigned gws[4] = {gw.x, gw.y, gw.z, gw.w};
                    float o[8];
#pragma unroll
                    for (int e = 0; e < 8; ++e) { const float gg = (e & 1) ? bf_hi(gws[e >> 1]) : bf_lo(gws[e >> 1]); o[e] = gg * acc[ai][bj][m][e >> 2][e & 3]; }
                    *(u32x4*)(Mo + (size_t)row * 1024 + col) = pack8(o);
                }
            }
    }
};
struct EpiB {
    static constexpr bool PERM = true, AFTER_DRAIN = false;
    bf16_t* Mo; const unsigned char* gates;
    __device__ __forceinline__ void operator()(const f32x4 (&acc)[2][2][4][2], const Unit& u, int wr, int wc, int fr, int fq) const {
        const int colbase = u.pn * 256 + 64 * wc + 8 * fq;
#pragma unroll
        for (int ai = 0; ai < 2; ++ai)
#pragma unroll
            for (int m = 0; m < 4; ++m) {
                const int row = EPI_ROW(u, ai, wr, m, fr);
#pragma unroll
                for (int bj = 0; bj < 2; ++bj) {
                    const int col = colbase + 32 * bj;
                    u32x4 gw = (u32x4){0u, 0u, 0u, 0u};
                    if (row < T_ALL) gw = *(const u32x4*)(gates + (size_t)row * 4096 + (size_t)(1024 + col) * 2);
                    const u32x4 mw = *(const u32x4*)(Mo + (size_t)row * 1024 + col);
                    const unsigned gws[4] = {gw.x, gw.y, gw.z, gw.w}, mws[4] = {mw.x, mw.y, mw.z, mw.w};
                    float o[8];
#pragma unroll
                    for (int e = 0; e < 8; ++e) { const float gg = (e & 1) ? bf_hi(gws[e >> 1]) : bf_lo(gws[e >> 1]); const float mm = (e & 1) ? bf_hi(mws[e >> 1]) : bf_lo(mws[e >> 1]);
                        o[e] = mm + gg * acc[ai][bj][m][e >> 2][e & 3]; }
                    *(u32x4*)(Mo + (size_t)row * 1024 + col) = pack8(o);
                }
            }
    }
};
struct EpiOut {
    static constexpr bool PERM = true, AFTER_DRAIN = false;
    float* out; const float *xp, *xs; const float* mod;
    __device__ __forceinline__ void operator()(const f32x4 (&acc)[2][2][4][2], const Unit& u, int wr, int wc, int fr, int fq) const {
        const int colbase = u.pn * 256 + 64 * wc + 8 * fq;
#pragma unroll
        for (int ai = 0; ai < 2; ++ai)
#pragma unroll
            for (int m = 0; m < 4; ++m) {
                const int row = EPI_ROW(u, ai, wr, m, fr);
                if (row < T_ALL) {
                    const int r12 = row < T_P ? (row >> 13) : 4 + ((row - T_P) >> 4);
                    const float* xr = row < T_P ? xp + (size_t)row * 1024 : xs + (size_t)(row - T_P) * 1024;
#pragma unroll
                    for (int bj = 0; bj < 2; ++bj) {
                        const int col = colbase + 32 * bj;
#pragma unroll
                        for (int n = 0; n < 2; ++n) {
                            const f32x4 xv = *(const f32x4*)(xr + col + 4 * n);
                            const f32x4 gv = *(const f32x4*)(mod + (size_t)r12 * 3072 + 2048 + col + 4 * n);
                            *(f32x4*)(out + (size_t)row * 1024 + col + 4 * n) = xv + gv * acc[ai][bj][m][n];
                        }
                    }
                }
            }
    }
};

struct Args { const float* in[24]; float* out; unsigned char* ws; };
typedef const Args __attribute__((address_space(4)))* KArgsPtr;
__device__ __forceinline__ Args kargs() {
#if defined(__HIP_DEVICE_COMPILE__)
    KArgsPtr p = (KArgsPtr)__builtin_amdgcn_kernarg_segment_ptr(); asm volatile("" : "+s"(p));
    Args r; for (int i = 0; i < 24; ++i) r.in[i] = p->in[i]; r.out = p->out; r.ws = p->ws; return r;
#else
    return Args{};
#endif
}

__device__ __forceinline__ int win_src_col(int np) {
    const int T = np >> 8, p = np & 255;
    const int j = 64 * ((p >> 5) & 3) + 32 * (p >> 7) + (p & 31);
    if (T < 16) return T * 256 + j;
    if (T < 24) return 9248 + (T - 16) * 256 + j;
    if (T < 32) return 4096 + (T - 24) * 256 + j;
    if (T < 44) return 6144 + (T - 32) * 256 + j;
    return j < 32 ? 9216 + j : -1;
}
__device__ __forceinline__ int gen_src_col(int np) { const int p = np & 255; return (np & ~255) + 64 * ((p >> 5) & 3) + 32 * (p >> 7) + (p & 31); }

__device__ __forceinline__ void transpose_item(const float* W, int K, int Nsrc, bf16_t* WT, int np0, int src0, int k0, const float* kscale, LAS float* scr, int lane) {
    float vv[32];
#pragma unroll
    for (int i = 0; i < 32; ++i) { const int kk = 2 * i + (lane >> 5); vv[i] = 0.f;
        if (src0 >= 0) vv[i] = W[(size_t)(k0 + kk) * Nsrc + src0 + (lane & 31)]; }
#pragma unroll
    for (int i = 0; i < 32; ++i) { const int kk = 2 * i + (lane >> 5); float v = vv[i];
        if (src0 >= 0 && kscale) v *= kscale[k0 + kk];
        scr[kk * 33 + (lane & 31)] = v; }
    asm volatile("s_waitcnt lgkmcnt(0)" ::: "memory");
    const int c = lane & 7;
#pragma unroll
    for (int j = 0; j < 4; ++j) { const int n = (lane >> 3) + 8 * j; const LAS float* s = scr + (8 * c) * 33 + n;
        u32x4 o; o.x = cvt_pk_bf16(s[0 * 33], s[1 * 33]); o.y = cvt_pk_bf16(s[2 * 33], s[3 * 33]); o.z = cvt_pk_bf16(s[4 * 33], s[5 * 33]); o.w = cvt_pk_bf16(s[6 * 33], s[7 * 33]);
        *(u32x4*)(WT + (size_t)(np0 + n) * K + k0 + 8 * c) = o; }
    asm volatile("s_waitcnt lgkmcnt(0)" ::: "memory");
}

__device__ __forceinline__ void phase0(LAS unsigned char* L) {
    const Args a = kargs();
    const int tid = tid_opaque(), lane = tid & 63, wave = tid >> 6;
    unsigned char* ws = a.ws;
    float* mod = (float*)(ws + WS_MOD);
    if (blockIdx.x < 96) {
        LAS float* sc = (LAS float*)L; LAS float* red = (LAS float*)(L + 49152);
        for (int i = tid; i < 12 * 1024; i += 512) { const int r = i >> 10, k = i & 1023; const float c = r < 4 ? a.in[2][r * 1024 + k] : a.in[3][(r - 4) * 1024 + k]; sc[i] = silu_f(c); }
        __syncthreads();
        const float* w_ada = a.in[9]; const float* b_ada = a.in[10];
        for (int item = blockIdx.x; item < 96; item += gridDim.x) {
            const int cc = tid & 31, kq = tid >> 5, col = 32 * item + cc;
            float acc[12];
#pragma unroll
            for (int r = 0; r < 12; ++r) acc[r] = 0.f;
#pragma unroll 8
            for (int kk = 0; kk < 64; ++kk) { const int k = 64 * kq + kk; const float w = w_ada[(size_t)k * 3072 + col];
#pragma unroll
                for (int r = 0; r < 12; ++r) acc[r] += sc[r * 1024 + k] * w; }
#pragma unroll
            for (int r = 0; r < 12; ++r) red[(kq * 32 + cc) * 12 + r] = acc[r];
            __syncthreads();
            if (tid < 384) { const int c2 = tid / 12, r = tid % 12; float s = 0.f; for (int q = 0; q < 16; ++q) s += red[(q * 32 + c2) * 12 + r];
                mod[r * 3072 + 32 * item + c2] = s + b_ada[32 * item + c2]; }
            __syncthreads();
        }
    }
    __syncthreads();
    LAS float* scr = (LAS float*)(L + wave * 16384);
    const int gw = blockIdx.x * 8 + wave, NGW = gridDim.x * 8;
    constexpr int I_IN = 16 * (N_WIN / 32), I_ATT = 16 * 32, I_SSD = 32 * 32, I_OUT = 16 * 32;
    for (int it = gw; it < I_IN + I_ATT + I_SSD + I_OUT; it += NGW) {
        int r = it;
        if (r < I_IN) { const int kb = r / (N_WIN / 32), ng = r % (N_WIN / 32); transpose_item(a.in[11], 1024, N_IN, (bf16_t*)(ws + WS_WIN), 32 * ng, win_src_col(32 * ng), 64 * kb, nullptr, scr, lane); continue; } r -= I_IN;
        if (r < I_ATT) { const int kb = r / 32, ng = r % 32; transpose_item(a.in[15], 1024, 1024, (bf16_t*)(ws + WS_WATT), 32 * ng, gen_src_col(32 * ng), 64 * kb, nullptr, scr, lane); continue; } r -= I_ATT;
        if (r < I_SSD) { const int kb = r / 32, ng = r % 32; transpose_item(a.in[22], 2048, 1024, (bf16_t*)(ws + WS_WSSD), 32 * ng, gen_src_col(32 * ng), 64 * kb, a.in[21], scr, lane); continue; } r -= I_SSD;
        { const int kb = r / 32, ng = r % 32; transpose_item(a.in[23], 1024, 1024, (bf16_t*)(ws + WS_WOUT), 32 * ng, gen_src_col(32 * ng), 64 * kb, nullptr, scr, lane); }
    }
}

__device__ __forceinline__ void phase1() {
    const Args a = kargs();
    const int tid = tid_opaque(), lane = tid & 63, wave = tid >> 6;
    const float* mod = (const float*)(a.ws + WS_MOD); const float* ng = a.in[8];
    bf16_t* H = (bf16_t*)(a.ws + WS_H);
    const int gw = blockIdx.x * 8 + wave, NGW = gridDim.x * 8;
    for (int row = gw; row < M_PAD; row += NGW) {
        u32x2* o8 = (u32x2*)(H + (size_t)row * 1024) + lane;
        if (row >= T_ALL) {
#pragma unroll
            for (int j = 0; j < 4; ++j) o8[64 * j] = (u32x2){0u, 0u};
            continue;
        }
        const float* xr = row < T_P ? a.in[0] + (size_t)row * 1024 : a.in[1] + (size_t)(row - T_P) * 1024;
        const int r12 = row < T_P ? (row >> 13) : 4 + ((row - T_P) >> 4);
        const float* mr = mod + (size_t)r12 * 3072;
        f32x4 v[4]; float s = 0.f;
#pragma unroll
        for (int j = 0; j < 4; ++j) { v[j] = *((const f32x4*)xr + lane + 64 * j); s += (v[j][0] * v[j][0] + v[j][1] * v[j][1]) + (v[j][2] * v[j][2] + v[j][3] * v[j][3]); }
#pragma unroll
        for (int o = 1; o < 64; o <<= 1) s += __shfl_xor(s, o);
        const float rinv = rsqrtf(s * (1.f / 1024.f) + EPS);
#pragma unroll
        for (int j = 0; j < 4; ++j) {
            const int c = 4 * (lane + 64 * j);
            const f32x4 gv = *(const f32x4*)(ng + c), sh = *(const f32x4*)(mr + c), scl = *(const f32x4*)(mr + 1024 + c);
            const f32x4 h = v[j] * rinv * gv * (scl + 1.f) + sh;
            o8[64 * j] = (u32x2){cvt_pk_bf16(h[0], h[1]), cvt_pk_bf16(h[2], h[3])};
        }
    }
}

template <bool DUMMY> __device__ __forceinline__ void attn_phase(LAS unsigned char* L) {
    const Args a = kargs();
    const int tid = tid_opaque(), lane = tid & 63, wave = __builtin_amdgcn_readfirstlane(tid >> 6);
    const int r = lane & 15, qq = lane >> 4, hw = wave >> 2, qt = wave & 3;
    bf16_t* Qb = (bf16_t*)(a.ws + WS_Q); const bf16_t* Kb = (const bf16_t*)(a.ws + WS_K); const bf16_t* Vb = (const bf16_t*)(a.ws + WS_V);
    const bf16_t* ZA = (const bf16_t*)(a.ws + WS_ZA);
    const float* cache_k = a.in[4]; const float* cache_v = a.in[5]; const float* rel_bias = a.in[14];
    LAS float* tbl = (LAS float*)(L + 73728);
    constexpr int NPROMPT = NB * 8 * 32, NITEMS = NPROMPT + NSB * 8;
    int tbl_hp = -1;
    for (int id = blockIdx.x; id < NITEMS; id += gridDim.x) {
        const bool samp = id >= NPROMPT;
        int hp, c0, b, sb;
        if (!samp) { hp = id & 7; c0 = 4 * (31 - ((id >> 3) & 31)); b = id >> 8; sb = 0; } else { const int x = id - NPROMPT; hp = x & 7; sb = x >> 3; c0 = 8; b = 0; }
        const int head = 2 * hp + hw;
        if (hp != tbl_hp) {
            for (int i = tid; i < 1280; i += 512) { const int hh = i >= 640 ? 1 : 0, j = i - 640 * hh; int d = j - 63; d = d > 256 ? 256 : d; tbl[i] = rel_bias[(2 * hp + hh) * 513 + d + 256] * LOG2E; }
            tbl_hp = hp;
        }
        const bool wactive = !samp || qt == 0;
        bf16x8 qf[4][2];
#pragma unroll
        for (int cc = 0; cc < 4; ++cc) {
            const int qrow = samp ? T_P + 16 * sb + r : b * SEQ + 64 * (c0 + cc) + 16 * qt + r;
#pragma unroll
            for (int ks = 0; ks < 2; ++ks) qf[cc][ks] = (wactive && (!samp || cc == 0)) ? *(const bf16x8*)(Qb + (size_t)qrow * 1024 + 64 * head + 32 * ks + 8 * qq) : (bf16x8){0, 0, 0, 0, 0, 0, 0, 0};
        }
        const int jlo = samp ? 0 : (c0 >= 8 ? c0 - 8 : 0), jhi = samp ? 8 : c0 + 3;
        u32x4 pre[4];
        auto load_blk = [&](int j) {
            if (tid < 256) {
                const int c16 = tid & 15;
#pragma unroll
                for (int e = 0; e < 4; ++e) { const int key = (tid >> 4) + 16 * e;
                    if (!samp) pre[e] = *(const u32x4*)(Kb + (size_t)(b * SEQ + 64 * j + key) * 1024 + 128 * hp + 8 * c16);
                    else if (j < 8) { const float* s = cache_k + ((size_t)(sb * 512 + 64 * j + key) * 1024 + 128 * hp + 8 * c16); const f32x4 x0 = *(const f32x4*)s, x1 = *(const f32x4*)(s + 4);
                        pre[e] = (u32x4){cvt_pk_bf16(x0[0], x0[1]), cvt_pk_bf16(x0[2], x0[3]), cvt_pk_bf16(x1[0], x1[1]), cvt_pk_bf16(x1[2], x1[3])}; }
                    else pre[e] = key < 16 ? *(const u32x4*)(Kb + (size_t)(T_P + 16 * sb + key) * 1024 + 128 * hp + 8 * c16) : (u32x4){0u, 0u, 0u, 0u}; }
            } else {
                const int u = tid - 256, kg = u >> 4, c16 = u & 15;
#pragma unroll
                for (int e = 0; e < 4; ++e) { const int key = 4 * kg + e;
                    if (!samp) pre[e] = *(const u32x4*)(Vb + (size_t)(b * SEQ + 64 * j + key) * 1024 + 128 * hp + 8 * c16);
                    else if (j < 8) { const float* s = cache_v + ((size_t)(sb * 512 + 64 * j + key) * 1024 + 128 * hp + 8 * c16); const f32x4 x0 = *(const f32x4*)s, x1 = *(const f32x4*)(s + 4);
                        pre[e] = (u32x4){cvt_pk_bf16(x0[0], x0[1]), cvt_pk_bf16(x0[2], x0[3]), cvt_pk_bf16(x1[0], x1[1]), cvt_pk_bf16(x1[2], x1[3])}; }
                    else pre[e] = key < 16 ? *(const u32x4*)(Vb + (size_t)(T_P + 16 * sb + key) * 1024 + 128 * hp + 8 * c16) : (u32x4){0u, 0u, 0u, 0u}; }
            }
        };
        auto write_blk = [&](int buf) {
            if (tid < 256) {
                const int c16 = tid & 15;
#pragma unroll
                for (int e = 0; e < 4; ++e) { const int key = (tid >> 4) + 16 * e; *(LAS u32x4*)(L + buf * 36864 + (c16 >> 3) * 9216 + key * 144 + (c16 & 7) * 16) = pre[e]; }
            } else {
                const int u = tid - 256, kg = u >> 4, c16 = u & 15;
#pragma unroll
                for (int dd = 0; dd < 8; ++dd) { u32x2 w; w.x = pk16(pre[0], pre[1], dd); w.y = pk16(pre[2], pre[3], dd);
                    *(LAS u32x2*)(L + buf * 36864 + 18432 + (c16 >> 3) * 9216 + (8 * (c16 & 7) + dd) * 144 + ((((kg >> 3) * 4 + (kg & 3)) ^ (((c16 & 7) >> 1) | ((c16 >> 3) << 2))) * 16) + ((kg >> 2) & 1) * 8) = w; }
            }
        };
        load_blk(jlo); write_blk(0);
        __syncthreads();
        f32x4 O[4][4]; float m_run[4], lsum[4];
#pragma unroll
        for (int cc = 0; cc < 4; ++cc) { m_run[cc] = -1e30f; lsum[cc] = 0.f;
#pragma unroll
            for (int td = 0; td < 4; ++td) O[cc][td] = (f32x4){0.f, 0.f, 0.f, 0.f}; }
        const LAS float* tblh = tbl + hw * 640;
        const float c256 = tblh[639];
        int cur = 0;
        for (int j = jlo; j <= jhi; ++j) {
            if (j < jhi) load_blk(j + 1);
            if (wactive) {
                const LAS unsigned char* Kl = L + cur * 36864 + hw * 9216; const LAS unsigned char* Vl = L + cur * 36864 + 18432 + hw * 9216;
#pragma unroll
                for (int cc = 0; cc < 4; ++cc) {
                    const int jrel = samp ? j : j - (c0 + cc - 8);
                    if ((samp && cc > 0) || jrel < 0 || jrel > 8) continue;
                    f32x4 st[4];
                    if (jrel <= 3) {
#pragma unroll
                        for (int t = 0; t < 4; ++t) st[t] = (f32x4){c256, c256, c256, c256};
                    } else {
                        const int jb0 = 575 + 16 * qt + r - 64 * jrel - 4 * qq;
#pragma unroll
                        for (int t = 0; t < 4; ++t)
#pragma unroll
                            for (int i = 0; i < 4; ++i) st[t][i] = tblh[jb0 - 16 * t - i];
                    }
#pragma unroll
                    for (int t = 0; t < 4; ++t)
#pragma unroll
                        for (int ks = 0; ks < 2; ++ks) { const bf16x8 kf = *(const LAS bf16x8*)(Kl + (16 * t + r) * 144 + (32 * ks + 8 * qq) * 2); st[t] = mfma16(kf, qf[cc][ks], st[t]); }
                    if (samp && jrel == 8) {
#pragma unroll
                        for (int t = 1; t < 4; ++t) st[t] = (f32x4){-1e30f, -1e30f, -1e30f, -1e30f};
                    }
                    float mx = st[0][0];
#pragma unroll
                    for (int t = 0; t < 4; ++t)
#pragma unroll
                        for (int i = 0; i < 4; ++i) mx = fmaxf(mx, st[t][i]);
                    mx = fmaxf(mx, __shfl_xor(mx, 16)); mx = fmaxf(mx, __shfl_xor(mx, 32));
                    const float m_old = m_run[cc], m_new = mx > m_old + 8.f ? mx : m_old;
                    if (__any(m_new != m_old)) {
                        const float alpha = __builtin_amdgcn_exp2f(m_old - m_new); m_run[cc] = m_new; lsum[cc] *= alpha;
#pragma unroll
                        for (int td = 0; td < 4; ++td) O[cc][td] *= alpha;
                    }
                    float ps = 0.f;
#pragma unroll
                    for (int t = 0; t < 4; ++t)
#pragma unroll
                        for (int i = 0; i < 4; ++i) { st[t][i] = __builtin_amdgcn_exp2f(st[t][i] - m_new); ps += st[t][i]; }
                    lsum[cc] += ps;
                    bf16x8 pf[2];
#pragma unroll
                    for (int kk = 0; kk < 2; ++kk) { u32x4 w; w.x = cvt_pk_bf16(st[2 * kk][0], st[2 * kk][1]); w.y = cvt_pk_bf16(st[2 * kk][2], st[2 * kk][3]);
                        w.z = cvt_pk_bf16(st[2 * kk + 1][0], st[2 * kk + 1][1]); w.w = cvt_pk_bf16(st[2 * kk + 1][2], st[2 * kk + 1][3]); pf[kk] = __builtin_bit_cast(bf16x8, w); }
#pragma unroll
                    for (int td = 0; td < 4; ++td)
#pragma unroll
                        for (int kk = 0; kk < 2; ++kk) { const bf16x8 vf = *(const LAS bf16x8*)(Vl + (16 * td + r) * 144 + (((kk * 4 + qq) ^ (td | (hw << 2))) * 16));
                            O[cc][td] = mfma16(vf, pf[kk], O[cc][td]); }
                }
            }
            if (j < jhi) write_blk(cur ^ 1);
            __syncthreads();
            cur ^= 1;
        }
        if (wactive && (!DUMMY || lsum[0] == 12345.678f)) {
#pragma unroll
            for (int cc = 0; cc < 4; ++cc) {
                if (samp && cc > 0) continue;
                const int qrow = samp ? T_P + 16 * sb + r : b * SEQ + 64 * (c0 + cc) + 16 * qt + r;
                float ls = lsum[cc]; ls += __shfl_xor(ls, 16); ls += __shfl_xor(ls, 32);
                const float inv = 1.f / ls;
#pragma unroll
                for (int td = 0; td < 4; ++td) {
                    const size_t off = (size_t)qrow * 1024 + 64 * head + 16 * td + 4 * qq;
                    const u32x2 zw = *(const u32x2*)(ZA + off);
                    u32x2 w; w.x = cvt_pk_bf16(O[cc][td][0] * inv * bf_lo(zw.x), O[cc][td][1] * inv * bf_hi(zw.x)); w.y = cvt_pk_bf16(O[cc][td][2] * inv * bf_lo(zw.y), O[cc][td][3] * inv * bf_hi(zw.y));
                    *(u32x2*)(Qb + off) = w;
                }
            }
        }
    }
}

__device__ __forceinline__ void conv_phase() {
    const Args a = kargs();
    const int tid = tid_opaque();
    bf16_t* XBC = (bf16_t*)(a.ws + WS_XBC); const bf16_t* HALO = (const bf16_t*)(a.ws + WS_HALO); bf16_t* XBCS = (bf16_t*)(a.ws + WS_XBCS);
    const float* cw = a.in[16]; const float* cb = a.in[17]; const float* st_conv = a.in[6];
    for (int id = blockIdx.x; id < 512 * 6; id += gridDim.x) {
        const int cbk = id % 6, chunk = id / 6, oct = tid & 63, run = tid >> 6, col = 512 * cbk + 8 * oct, row0 = 64 * chunk + 8 * run;
        u32x4 u[11];
#pragma unroll
        for (int i = 0; i < 11; ++i) {
            if (i < 3 && run == 0) u[i] = (chunk & 127) == 0 ? (u32x4){0u, 0u, 0u, 0u} : *(const u32x4*)(HALO + ((size_t)(chunk - 1) * 3 + i) * CONVC + col);
            else u[i] = *(const u32x4*)(XBC + (size_t)(row0 - 3 + i) * CONVC + col);
        }
        asm volatile("s_waitcnt vmcnt(0)" ::: "memory");
        __syncthreads();
        float w[4][8], bb[8];
#pragma unroll
        for (int e = 0; e < 8; ++e) { bb[e] = cb[col + e];
#pragma unroll
            for (int j = 0; j < 4; ++j) w[j][e] = cw[j * CONVC + col + e]; }
#pragma unroll
        for (int t = 0; t < 8; ++t) {
            float o[8];
#pragma unroll
            for (int e = 0; e < 8; ++e) {
                float s = bb[e];
#pragma unroll
                for (int j = 0; j < 4; ++j) { const unsigned wd = (e >> 1) == 0 ? u[t + j].x : (e >> 1) == 1 ? u[t + j].y : (e >> 1) == 2 ? u[t + j].z : u[t + j].w; s += w[j][e] * ((e & 1) ? bf_hi(wd) : bf_lo(wd)); }
                o[e] = silu_f(s);
            }
            *(u32x4*)(XBC + (size_t)(row0 + t) * CONVC + col) = pack8(o);
        }
        __syncthreads();
    }
    for (int id = blockIdx.x * 512 + tid; id < T_S * 384; id += gridDim.x * 512) {
        const int oct = id % 384, rr = id / 384, sb = rr >> 4, t = rr & 15, col = 8 * oct;
        float o[8];
#pragma unroll
        for (int e = 0; e < 8; ++e) o[e] = cb[col + e];
#pragma unroll
        for (int j = 0; j < 4; ++j) {
            const int tt = t - 3 + j; float xv[8];
            if (tt >= 0) { const u32x4 q = *(const u32x4*)(XBC + (size_t)(T_P + 16 * sb + tt) * CONVC + col);
                xv[0] = bf_lo(q.x); xv[1] = bf_hi(q.x); xv[2] = bf_lo(q.y); xv[3] = bf_hi(q.y); xv[4] = bf_lo(q.z); xv[5] = bf_hi(q.z); xv[6] = bf_lo(q.w); xv[7] = bf_hi(q.w); }
            else { const float* s = st_conv + ((size_t)(sb * 3 + (tt + 3)) * CONVC + col);
#pragma unroll
                for (int e = 0; e < 8; ++e) xv[e] = s[e]; }
#pragma unroll
            for (int e = 0; e < 8; ++e) o[e] += cw[j * CONVC + col + e] * xv[e];
        }
#pragma unroll
        for (int e = 0; e < 8; ++e) o[e] = silu_f(o[e]);
        *(u32x4*)(XBCS + (size_t)rr * CONVC + col) = pack8(o);
    }
}

constexpr int SC_CS = 0, SC_BS = 17408, SC_BT = 34816, SC_XT = 53248, SC_LS = 62464, SC_HS = 71680, SC_XS = 89088, SC_ZS = 98304, SC_YS = 107520,
              SC_ACS = 116736, SC_WLS = 116992, SC_DTS = 117248, SC_SSL = 117504;
template <bool DUMMY> __device__ __forceinline__ void scan_phase(LAS unsigned char* L) {
    const Args a = kargs();
    const int tid = tid_opaque(), lane = tid & 63, wave = __builtin_amdgcn_readfirstlane(tid >> 6);
    const int r = lane & 15, qq = lane >> 4;
    const bf16_t* XBC = (const bf16_t*)(a.ws + WS_XBC); bf16_t* ZS = (bf16_t*)(a.ws + WS_ZS); const float* DT = (const float*)(a.ws + WS_DT);
    float* ssqp = (float*)(a.ws + WS_SSQP); float* ssqs = (float*)(a.ws + WS_SSQS);
    const float* a_log = a.in[19]; const float* d_skip = a.in[20];
    bf16_t* Y1 = (bf16_t*)(a.ws + WS_H); float* SST0 = (float*)(a.ws + WS_SST0); float* SST1 = (float*)(a.ws + WS_SST1); float* ACUM = (float*)(a.ws + WS_ACUM); float* ATOT = (float*)(a.ws + WS_ATOT);
    for (int id = blockIdx.x; id < NB * 32 * 2; id += gridDim.x) {
        const int combo = (id & 7) * 4 + (id >> 6), seg = combo & 1, g = (combo >> 1) & 3, b = combo >> 3, h = g * 8 + ((id >> 3) & 7), ck0 = 64 * seg;
        float arun = 0.f;
        const float a_h = -__expf(a_log[h]) * LOG2E, dsk = d_skip[h];
        f32x4 Hacc[4];
#pragma unroll
        for (int t2 = 0; t2 < 4; ++t2) Hacc[t2] = (f32x4){0.f, 0.f, 0.f, 0.f};
        for (int i = tid; i < 17408 / 4; i += 512) *(LAS unsigned*)(L + SC_HS + 4 * i) = 0u;
        u32x4 pre[8]; float dtv = 0.f;
        const int xcol = 64 * h;
        auto load_ck = [&](int ck) {
            const size_t rowbase = (size_t)b * SEQ + 64 * ck;
            if (tid < 256) { const int u = tid & 127, rg = u >> 4, c = u & 15; const int col = (tid < 128 ? 2048 : 2560) + 128 * g + 8 * c;
#pragma unroll
                for (int e = 0; e < 8; ++e) pre[e] = *(const u32x4*)(XBC + (rowbase + 8 * rg + e) * CONVC + col);
            } else if (tid < 320) { const int u = tid - 256, rg = u >> 3, c = u & 7;
#pragma unroll
                for (int e = 0; e < 8; ++e) pre[e] = *(const u32x4*)(XBC + (rowbase + 8 * rg + e) * CONVC + xcol + 8 * c);
            } else if (tid < 384) { const int u = tid - 320, rg = u >> 3, c = u & 7;
#pragma unroll
                for (int e = 0; e < 8; ++e) pre[e] = *(const u32x4*)(ZS + (rowbase + 8 * rg + e) * SSDW + xcol + 8 * c);
            } else if (tid >= 448) dtv = DT[(rowbase + lane) * 32 + h];
        };
        int wck = ck0;
        auto write_ck = [&]() {
            if (tid < 256) { const int u = tid & 127, rg = u >> 4, c = u & 15; const int base = tid < 128 ? SC_BS : SC_CS;
#pragma unroll
                for (int e = 0; e < 8; ++e) *(LAS u32x4*)(L + base + (8 * rg + e) * 272 + c * 16) = pre[e];
                if (tid < 128) {
#pragma unroll
                    for (int dd = 0; dd < 8; ++dd) { u32x4 w; w.x = pk16(pre[0], pre[1], dd); w.y = pk16(pre[2], pre[3], dd); w.z = pk16(pre[4], pre[5], dd); w.w = pk16(pre[6], pre[7], dd);
                        *(LAS u32x4*)(L + SC_BT + (8 * c + dd) * 144 + ((rg ^ (c >> 1)) * 16)) = w; }
                }
            } else if (tid < 320) { const int u = tid - 256, rg = u >> 3, c = u & 7;
#pragma unroll
                for (int e = 0; e < 8; ++e) *(LAS u32x4*)(L + SC_XS + (8 * rg + e) * 144 + c * 16) = pre[e];
#pragma unroll
                for (int dd = 0; dd < 8; ++dd) { u32x4 w; w.x = pk16(pre[0], pre[1], dd); w.y = pk16(pre[2], pre[3], dd); w.z = pk16(pre[4], pre[5], dd); w.w = pk16(pre[6], pre[7], dd);
                    *(LAS u32x4*)(L + SC_XT + (8 * c + dd) * 144 + ((rg ^ (c >> 1)) * 16)) = w; }
            } else if (tid < 384) { const int u = tid - 320, rg = u >> 3, c = u & 7;
#pragma unroll
                for (int e = 0; e < 8; ++e) *(LAS u32x4*)(L + SC_ZS + (8 * rg + e) * 144 + c * 16) = pre[e];
            } else if (tid >= 448) {
                float x = dtv * a_h;
#pragma unroll
                for (int o = 1; o < 64; o <<= 1) { const float y = __shfl_up(x, o); if (lane >= o) x += y; }
                const float tot = __shfl(x, 63);
                if (seg == 1) ACUM[(size_t)(b * 32 + h) * 4096 + 64 * (wck - 64) + lane] = arun + x;
                arun += tot;
                ((LAS float*)(L + SC_ACS))[lane] = x; ((LAS float*)(L + SC_WLS))[lane] = dtv * __builtin_amdgcn_exp2f(tot - x); ((LAS float*)(L + SC_DTS))[lane] = dtv;
            }
        };
        load_ck(ck0);
        const int tl = wave >> 1, tpb = 2 * (wave & 1);
        for (int ck = ck0; ck < ck0 + 64; ++ck) {
            const size_t rowbase = (size_t)b * SEQ + 64 * ck;
            wck = ck;
            write_ck();
            if (ck + 1 < ck0 + 64) load_ck(ck + 1);
            __syncthreads();
            {
#pragma unroll
                for (int tsi = 0; tsi < 2; ++tsi) {
                    const int ts = tpb + tsi; const int l = 16 * tl + r;
                    u32x2 w = (u32x2){0u, 0u};
                    if (ts <= tl) {
                        f32x4 cbv = (f32x4){0.f, 0.f, 0.f, 0.f};
#pragma unroll
                        for (int ks = 0; ks < 4; ++ks) { const bf16x8 af = *(const LAS bf16x8*)(L + SC_BS + (16 * ts + r) * 272 + (32 * ks + 8 * qq) * 2);
                            const bf16x8 bf = *(const LAS bf16x8*)(L + SC_CS + (16 * tl + r) * 272 + (32 * ks + 8 * qq) * 2); cbv = mfma16(af, bf, cbv); }
                        const float al = ((const LAS float*)(L + SC_ACS))[l];
                        const f32x4 as4 = *(const LAS f32x4*)(L + SC_ACS + (16 * ts + 4 * qq) * 4), dt4 = *(const LAS f32x4*)(L + SC_DTS + (16 * ts + 4 * qq) * 4);
                        float v[4];
#pragma unroll
                        for (int i = 0; i < 4; ++i) { const int s = 16 * ts + 4 * qq + i; const float d = fminf(al - as4[i], 0.f); v[i] = s <= l ? cbv[i] * __builtin_amdgcn_exp2f(d) * dt4[i] : 0.f; }
                        w.x = cvt_pk_bf16(v[0], v[1]); w.y = cvt_pk_bf16(v[2], v[3]);
                    }
                    *(LAS u32x2*)(L + SC_LS + l * 144 + (16 * ts + 4 * qq) * 2) = w;
                }
            }
            f32x4 yst[2]; yst[0] = (f32x4){0.f, 0.f, 0.f, 0.f}; yst[1] = (f32x4){0.f, 0.f, 0.f, 0.f};
#pragma unroll
            for (int ks = 0; ks < 4; ++ks) { const bf16x8 bf = *(const LAS bf16x8*)(L + SC_CS + (16 * tl + r) * 272 + (32 * ks + 8 * qq) * 2);
#pragma unroll
                for (int tpi = 0; tpi < 2; ++tpi) { const bf16x8 af = *(const LAS bf16x8*)(L + SC_HS + (16 * (tpb + tpi) + r) * 272 + (32 * ks + 8 * qq) * 2); yst[tpi] = mfma16(af, bf, yst[tpi]); } }
            __syncthreads();
            {
                f32x4 yin[2]; yin[0] = (f32x4){0.f, 0.f, 0.f, 0.f}; yin[1] = (f32x4){0.f, 0.f, 0.f, 0.f};
#pragma unroll
                for (int ks = 0; ks < 2; ++ks) { const bf16x8 bf = *(const LAS bf16x8*)(L + SC_LS + (16 * tl + r) * 144 + (32 * ks + 8 * qq) * 2);
#pragma unroll
                    for (int tpi = 0; tpi < 2; ++tpi) { const bf16x8 af = *(const LAS bf16x8*)(L + SC_XT + (16 * (tpb + tpi) + r) * 144 + (((4 * ks + qq) ^ (tpb + tpi)) * 16)); yin[tpi] = mfma16(af, bf, yin[tpi]); } }
                const int l = 16 * tl + r;
                const float el = __builtin_amdgcn_exp2f(((const LAS float*)(L + SC_ACS))[l]);
                float ss = 0.f;
#pragma unroll
                for (int tpi = 0; tpi < 2; ++tpi) {
                    const int po = (16 * (tpb + tpi) + 4 * qq) * 2;
                    const u32x2 xw = *(const LAS u32x2*)(L + SC_XS + l * 144 + po), zw = *(const LAS u32x2*)(L + SC_ZS + l * 144 + po);
                    const float xv[4] = {bf_lo(xw.x), bf_hi(xw.x), bf_lo(xw.y), bf_hi(xw.y)}, zv[4] = {bf_lo(zw.x), bf_hi(zw.x), bf_lo(zw.y), bf_hi(zw.y)};
                    float gy[4];
#pragma unroll
                    for (int i = 0; i < 4; ++i) { gy[i] = (yin[tpi][i] + el * yst[tpi][i] + dsk * xv[i]) * zv[i]; ss += gy[i] * gy[i]; }
                    *(LAS u32x2*)(L + SC_YS + l * 144 + po) = (u32x2){cvt_pk_bf16(gy[0], gy[1]), cvt_pk_bf16(gy[2], gy[3])};
                }
                ss += __shfl_xor(ss, 16); ss += __shfl_xor(ss, 32);
                if (qq == 0) ((LAS float*)(L + SC_SSL))[(wave & 1) * 64 + l] = ss;
                const float E = __builtin_amdgcn_exp2f(((const LAS float*)(L + SC_ACS))[63]);
                const int t2 = wave & 3, nb = 4 * (wave >> 2);
                bf16x8 xsc[2];
#pragma unroll
                for (int ks = 0; ks < 2; ++ks) {
                    const u32x4 raw = *(const LAS u32x4*)(L + SC_XT + (16 * t2 + r) * 144 + (((4 * ks + qq) ^ t2) * 16));
                    const f32x4 w0 = *(const LAS f32x4*)(L + SC_WLS + (32 * ks + 8 * qq) * 4), w1 = *(const LAS f32x4*)(L + SC_WLS + (32 * ks + 8 * qq + 4) * 4);
                    u32x4 sc; sc.x = cvt_pk_bf16(bf_lo(raw.x) * w0[0], bf_hi(raw.x) * w0[1]); sc.y = cvt_pk_bf16(bf_lo(raw.y) * w0[2], bf_hi(raw.y) * w0[3]);
                    sc.z = cvt_pk_bf16(bf_lo(raw.z) * w1[0], bf_hi(raw.z) * w1[1]); sc.w = cvt_pk_bf16(bf_lo(raw.w) * w1[2], bf_hi(raw.w) * w1[3]);
                    xsc[ks] = __builtin_bit_cast(bf16x8, sc);
                }
#pragma unroll
                for (int j = 0; j < 4; ++j) {
                    Hacc[j] *= E;
#pragma unroll
                    for (int ks = 0; ks < 2; ++ks) { const bf16x8 bfr = *(const LAS bf16x8*)(L + SC_BT + (16 * (nb + j) + r) * 144 + (((4 * ks + qq) ^ ((nb + j) & 7)) * 16)); Hacc[j] = mfma16(bfr, xsc[ks], Hacc[j]); }
                    *(LAS u32x2*)(L + SC_HS + (16 * t2 + r) * 272 + (16 * (nb + j) + 4 * qq) * 2) = (u32x2){cvt_pk_bf16(Hacc[j][0], Hacc[j][1]), cvt_pk_bf16(Hacc[j][2], Hacc[j][3])};
                }
            }
            __syncthreads();
            if (!DUMMY) { const int row = tid >> 3, c = tid & 7; const u32x4 v = *(const LAS u32x4*)(L + SC_YS + row * 144 + c * 16);
              if (seg == 0) *(u32x4*)(ZS + (rowbase + row) * SSDW + xcol + 8 * c) = v;
              else *(u32x4*)(Y1 + ((size_t)b * 4096 + 64 * (ck - 64) + row) * SSDW + xcol + 8 * c) = v; }
            if (!DUMMY && seg == 0 && tid < 64) { const float v = ((const LAS float*)(L + SC_SSL))[tid] + ((const LAS float*)(L + SC_SSL))[64 + tid];
                ssqp[(size_t)(g * 8 + (h & 7)) * T_P + rowbase + tid] = v; }
        }
#pragma unroll
        for (int j = 0; j < 4; ++j) *(f32x4*)((seg == 0 ? SST0 : SST1) + ((size_t)((b * 32 + h) * 64 + 16 * (wave & 3) + r)) * 128 + 16 * (4 * (wave >> 2) + j) + 4 * qq) = Hacc[j];
        if (seg == 1 && tid == 448) ATOT[b * 32 + h] = arun;
        __syncthreads();
    }
    {
        const bf16_t* XBCS = (const bf16_t*)(a.ws + WS_XBCS); const float* st_ssm = a.in[7];
        LAS float* xs = (LAS float*)L;
        LAS float* Bv = xs + 1024;
        LAS float* Cv = Bv + 2048;
        LAS float* acs = Cv + 2048;
        LAS float* dtl = acs + 16;
        LAS float* Lm = dtl + 16;
        LAS float* wl16 = Lm + 256;
        LAS float* hst = wl16 + 16;
        const int G = gridDim.x;
        const int s0 = (int)blockIdx.x, sstep = G;
        for (int id = DUMMY ? NSB * 32 : s0; id < NSB * 32; id += sstep) {
            const int h = id & 31, sb = id >> 5, g = h >> 3;
            const float a_h = -__expf(a_log[h]), dsk = d_skip[h];
            __syncthreads();
            _Pragma("clang loop unroll(disable) vectorize(disable)") for (int i = tid; i < 1024; i += 512) { const int t = i >> 6, p = i & 63; xs[i] = __uint_as_float((unsigned)XBCS[(size_t)(16 * sb + t) * CONVC + 64 * h + p] << 16); }
            _Pragma("clang loop unroll(disable) vectorize(disable)") for (int i = tid; i < 2048; i += 512) { const int t = i >> 7, n = i & 127; Bv[i] = __uint_as_float((unsigned)XBCS[(size_t)(16 * sb + t) * CONVC + 2048 + 128 * g + n] << 16);
                Cv[i] = __uint_as_float((unsigned)XBCS[(size_t)(16 * sb + t) * CONVC + 2560 + 128 * g + n] << 16); }
            _Pragma("clang loop unroll(disable) vectorize(disable)") for (int i = tid; i < 8192; i += 512) { const int p = i >> 7, n = i & 127; hst[p * 129 + n] = st_ssm[((size_t)(sb * 32 + h) * 64 + p) * 128 + n]; }
            if (tid == 0) { float c = 0.f; for (int t = 0; t < 16; ++t) { const float d = DT[(size_t)(T_P + 16 * sb + t) * 32 + h]; c += d * a_h; acs[t] = c; dtl[t] = d; }
                for (int t = 0; t < 16; ++t) wl16[t] = dtl[t] * __expf(c - acs[t]); }
            __syncthreads();
            if (tid < 256) { const int l = tid >> 4, s = tid & 15; float v = 0.f;
                if (s <= l) { float dsum = 0.f; _Pragma("clang loop unroll_count(4)") for (int n = 0; n < 128; ++n) dsum += Cv[l * 128 + n] * Bv[s * 128 + n]; v = dsum * __expf(acs[l] - acs[s]) * dtl[s]; }
                Lm[tid] = v; }
            __syncthreads();
            _Pragma("clang loop unroll(disable) vectorize(disable)") for (int j = 0; j < 2; ++j) {
                const int i = tid + 512 * j, l = i >> 6, p = i & 63;
                float y = 0.f;
                _Pragma("clang loop unroll(disable) vectorize(disable)") for (int s = 0; s <= l; ++s) y += Lm[l * 16 + s] * xs[s * 64 + p];
                float ys = 0.f;
                _Pragma("clang loop unroll_count(4)") for (int n = 0; n < 128; ++n) ys += Cv[l * 128 + n] * hst[p * 129 + n];
                y += __expf(acs[l]) * ys + dsk * xs[l * 64 + p];
                const size_t off = (size_t)(T_P + 16 * sb + l) * SSDW + 64 * h + p;
                const float gy = y * __uint_as_float((unsigned)ZS[off] << 16);
                float ss = gy * gy;
#pragma unroll
                for (int o = 1; o < 64; o <<= 1) ss += __shfl_xor(ss, o);
                if (lane == 0) ssqs[(size_t)(sb * 32 + h) * 32 + l] = ss;
                ZS[off] = (bf16_t)(cvt_pk_bf16(gy, 0.f) & 0xffffu);
            }
            const float E = __expf(acs[15]);
            _Pragma("clang loop unroll(disable) vectorize(disable)") for (int j = 0; j < 16; ++j) {
                const int i = tid + 512 * j, p = i >> 7, n = i & 127;
                float v = hst[p * 129 + n] * E;
                _Pragma("clang loop unroll(disable) vectorize(disable)") for (int l = 0; l < 16; ++l) v += Bv[l * 128 + n] * xs[l * 64 + p] * wl16[l];
                a.out[O_HS + ((size_t)(sb * 32 + h) * 64 + p) * 128 + n] = v;
            }
        }
        __syncthreads();
    }
}

template <bool DUMMY> __device__ __forceinline__ void scanfix_phase(LAS unsigned char* L) {
    const Args a = kargs();
    const int tid = tid_opaque(), lane = tid & 63, wave = __builtin_amdgcn_readfirstlane(tid >> 6);
    const int r = lane & 15, qq = lane >> 4;
    const bf16_t* XBC = (const bf16_t*)(a.ws + WS_XBC); bf16_t* ZS = (bf16_t*)(a.ws + WS_ZS); const bf16_t* Y1 = (const bf16_t*)(a.ws + WS_H);
    const float* SST0 = (const float*)(a.ws + WS_SST0); const float* SST1 = (const float*)(a.ws + WS_SST1); const float* ACUM = (const float*)(a.ws + WS_ACUM); const float* ATOT = (const float*)(a.ws + WS_ATOT);
    float* ssqp = (float*)(a.ws + WS_SSQP);
    constexpr int FX_HS = 0, FX_CS = 17408, FX_SSL = 34816;
    for (int id = blockIdx.x; id < NB * 32 * 2; id += gridDim.x) {
        const int combo = (id & 7) * 4 + (id >> 6), half = combo & 1, g = (combo >> 1) & 3, b = combo >> 3, h = g * 8 + ((id >> 3) & 7), bh = b * 32 + h;
        __syncthreads();
        const float eA = __builtin_amdgcn_exp2f(ATOT[bh]);
#pragma unroll
        for (int j = 0; j < 4; ++j) {
            const int e4 = tid + 512 * j, p = e4 >> 5, n = (e4 & 31) * 4;
            const f32x4 s0 = *(const f32x4*)(SST0 + ((size_t)bh * 64 + p) * 128 + n);
            *(LAS u32x2*)(L + FX_HS + p * 272 + n * 2) = (u32x2){cvt_pk_bf16(s0[0], s0[1]), cvt_pk_bf16(s0[2], s0[3])};
            if (!DUMMY && half == 0) { const f32x4 s1 = *(const f32x4*)(SST1 + ((size_t)bh * 64 + p) * 128 + n); *(f32x4*)(a.out + O_HP + ((size_t)bh * 64 + p) * 128 + n) = s1 + s0 * eA; }
        }
        const int tl = wave >> 1, tpb = 2 * (wave & 1);
        u32x4 cpre[2];
        { const size_t rb0 = (size_t)b * SEQ + 64 * (64 + 32 * half);
#pragma unroll
          for (int j = 0; j < 2; ++j) { const int e = tid + 512 * j, row = e >> 4, c = e & 15; cpre[j] = *(const u32x4*)(XBC + (rb0 + row) * CONVC + 2560 + 128 * g + 8 * c); } }
        for (int cki = 0; cki < 32; ++cki) {
            const int ck = 64 + 32 * half + cki;
            const size_t rowbase = (size_t)b * SEQ + 64 * ck, y1base = (size_t)b * 4096 + 64 * (ck - 64);
#pragma unroll
            for (int j = 0; j < 2; ++j) { const int e = tid + 512 * j, row = e >> 4, c = e & 15; *(LAS u32x4*)(L + FX_CS + row * 272 + c * 16) = cpre[j]; }
            __syncthreads();
            if (cki + 1 < 32) {
#pragma unroll
                for (int j = 0; j < 2; ++j) { const int e = tid + 512 * j, row = e >> 4, c = e & 15; cpre[j] = *(const u32x4*)(XBC + (rowbase + 64 + row) * CONVC + 2560 + 128 * g + 8 * c); }
            }
            const int l = 16 * tl + r;
            const float acv = ACUM[(size_t)bh * 4096 + 64 * (ck - 64) + l];
            u32x2 yw[2], zw[2];
#pragma unroll
            for (int tpi = 0; tpi < 2; ++tpi) { const int col = 64 * h + 16 * (tpb + tpi) + 4 * qq;
                yw[tpi] = *(const u32x2*)(Y1 + (y1base + l) * SSDW + col); zw[tpi] = *(const u32x2*)(ZS + (rowbase + l) * SSDW + col); }
            f32x4 yf[2]; yf[0] = (f32x4){0.f, 0.f, 0.f, 0.f}; yf[1] = (f32x4){0.f, 0.f, 0.f, 0.f};
#pragma unroll
            for (int ks = 0; ks < 4; ++ks) { const bf16x8 bf = *(const LAS bf16x8*)(L + FX_CS + (16 * tl + r) * 272 + (32 * ks + 8 * qq) * 2);
#pragma unroll
                for (int tpi = 0; tpi < 2; ++tpi) { const bf16x8 af = *(const LAS bf16x8*)(L + FX_HS + (16 * (tpb + tpi) + r) * 272 + (32 * ks + 8 * qq) * 2); yf[tpi] = mfma16(af, bf, yf[tpi]); } }
            const float el = __builtin_amdgcn_exp2f(acv);
            float ss = 0.f;
#pragma unroll
            for (int tpi = 0; tpi < 2; ++tpi) {
                const int col = 64 * h + 16 * (tpb + tpi) + 4 * qq;
                float gy[4];
                gy[0] = bf_lo(yw[tpi].x) + el * yf[tpi][0] * bf_lo(zw[tpi].x); gy[1] = bf_hi(yw[tpi].x) + el * yf[tpi][1] * bf_hi(zw[tpi].x);
                gy[2] = bf_lo(yw[tpi].y) + el * yf[tpi][2] * bf_lo(zw[tpi].y); gy[3] = bf_hi(yw[tpi].y) + el * yf[tpi][3] * bf_hi(zw[tpi].y);
#pragma unroll
                for (int i = 0; i < 4; ++i) ss += gy[i] * gy[i];
                if (!DUMMY || ss == 12345.678f) *(u32x2*)(ZS + (rowbase + l) * SSDW + col) = (u32x2){cvt_pk_bf16(gy[0], gy[1]), cvt_pk_bf16(gy[2], gy[3])};
            }
            ss += __shfl_xor(ss, 16); ss += __shfl_xor(ss, 32);
            if (qq == 0) ((LAS float*)(L + FX_SSL))[(wave & 1) * 64 + l] = ss;
            __syncthreads();
            if (!DUMMY && tid < 64) ssqp[(size_t)h * T_P + rowbase + tid] = ((const LAS float*)(L + FX_SSL))[tid] + ((const LAS float*)(L + FX_SSL))[64 + tid];
        }
    }
}

__device__ __forceinline__ void ynorm_phase() {
    const Args a = kargs();
    const int tid = tid_opaque(), lane = tid & 63, wave = tid >> 6;
    bf16_t* Y = (bf16_t*)(a.ws + WS_ZS); const float* ssqp = (const float*)(a.ws + WS_SSQP); const float* ssqs = (const float*)(a.ws + WS_SSQS);
    const int gw = blockIdx.x * 8 + wave, NGW = gridDim.x * 8;
    for (int row = gw; row < T_ALL; row += NGW) {
        float sv = 0.f;
        if (lane < 32) sv = row < T_P ? ssqp[(size_t)lane * T_P + row] : ssqs[(size_t)(((row - T_P) >> 4) * 32 + lane) * 32 + ((row - T_P) & 15)];
        sv += __shfl_xor(sv, 1); sv += __shfl_xor(sv, 2); sv += __shfl_xor(sv, 4);
        const float s4[4] = {__shfl(sv, 0), __shfl(sv, 8), __shfl(sv, 16), __shfl(sv, 24)};
        u32x4* p = (u32x4*)(Y + (size_t)row * SSDW) + lane;
#pragma unroll
        for (int j = 0; j < 4; ++j) {
            const float rinv = rsqrtf(s4[j] * (1.f / 512.f) + EPS);
            const u32x4 v = p[64 * j];
            u32x4 o; o.x = cvt_pk_bf16(bf_lo(v.x) * rinv, bf_hi(v.x) * rinv); o.y = cvt_pk_bf16(bf_lo(v.y) * rinv, bf_hi(v.y) * rinv);
            o.z = cvt_pk_bf16(bf_lo(v.z) * rinv, bf_hi(v.z) * rinv); o.w = cvt_pk_bf16(bf_lo(v.w) * rinv, bf_hi(v.w) * rinv);
            p[64 * j] = o;
        }
    }
}

template <int MODE>
__device__ __forceinline__ void mini_gemm(const bf16_t* A, const bf16_t* Bt, int K, bf16_t* Mo, const unsigned char* gates, float* out, const float* xs, const float* mod) {
    const int tid = tid_opaque(), lane = tid & 63, wave = __builtin_amdgcn_readfirstlane(tid >> 6), r = lane & 15, qq = lane >> 4;
    for (int t = blockIdx.x; t < 64; t += gridDim.x) {
        const int n0 = 16 * t, jj = n0 & 255;
        const int prow = (n0 & ~255) + 128 * ((jj >> 5) & 1) + 32 * (jj >> 6) + (jj & 31);
        const bf16_t* ap = A + (size_t)(T_P + 16 * wave + r) * K + 8 * qq;
        const bf16_t* bp = Bt + (size_t)(prow + r) * K + 8 * qq;
        f32x4 acc = (f32x4){0.f, 0.f, 0.f, 0.f};
#pragma unroll 8
        for (int k = 0; k < K; k += 32) { const bf16x8 af = *(const bf16x8*)(ap + k), bf = *(const bf16x8*)(bp + k); acc = mfma16(bf, af, acc); }
        const int row = T_P + 16 * wave + r, col = n0 + 4 * qq;
        if (MODE == 0) {
            const u32x2 gw = *(const u32x2*)(gates + (size_t)row * 4096 + (size_t)col * 2);
            *(u32x2*)(Mo + (size_t)row * 1024 + col) = (u32x2){cvt_pk_bf16(bf_lo(gw.x) * acc[0], bf_hi(gw.x) * acc[1]), cvt_pk_bf16(bf_lo(gw.y) * acc[2], bf_hi(gw.y) * acc[3])};
        } else if (MODE == 1) {
            const u32x2 gw = *(const u32x2*)(gates + (size_t)row * 4096 + (size_t)(1024 + col) * 2); const u32x2 mw = *(const u32x2*)(Mo + (size_t)row * 1024 + col);
            *(u32x2*)(Mo + (size_t)row * 1024 + col) = (u32x2){cvt_pk_bf16(bf_lo(mw.x) + bf_lo(gw.x) * acc[0], bf_hi(mw.x) + bf_hi(gw.x) * acc[1]), cvt_pk_bf16(bf_lo(mw.y) + bf_lo(gw.y) * acc[2], bf_hi(mw.y) + bf_hi(gw.y) * acc[3])};
        } else {
            const int r12 = 4 + ((row - T_P) >> 4);
            const f32x4 xv = *(const f32x4*)(xs + (size_t)(row - T_P) * 1024 + col), gv = *(const f32x4*)(mod + (size_t)r12 * 3072 + 2048 + col);
            *(f32x4*)(out + (size_t)row * 1024 + col) = xv + gv * acc;
        }
    }
}

#define XB_TMO      128
#define XB_XCNT(j)  (256  + 64 * (j))
#define XB_XSUB(j)  (1280 + 64 * (j))
#define XB_XGEN(j)  (2304 + 64 * (j))
#define XB_TOP      3328
#define XB_TOPGEN   3392
#define XCD_BAR_WORDS 3456
#define XB_SPIN_CAP (1u << 18)

__device__ __forceinline__ unsigned xb_ld(unsigned* p)              { return __hip_atomic_load(p, __ATOMIC_RELAXED, __HIP_MEMORY_SCOPE_AGENT); }
__device__ __forceinline__ unsigned xb_add(unsigned* p, unsigned v) { return __hip_atomic_fetch_add(p, v, __ATOMIC_RELAXED, __HIP_MEMORY_SCOPE_AGENT); }
__device__ __forceinline__ unsigned xb_xcc_id() { return (unsigned)__builtin_amdgcn_s_getreg((3 << 11) | 20) & 0xFu; }
#define XB_SPIN(cond, bar) do { unsigned _sp = 0; while (cond) { __builtin_amdgcn_s_sleep(1); \
    if ((++_sp & 255u) == 0u) { if (xb_ld(&(bar)[XB_TMO])) break; if (_sp > XB_SPIN_CAP) { atomicAdd(&(bar)[XB_TMO], 1u); break; } } } } while (0)

struct XcdBarrier {
    unsigned* bar; unsigned x;
    volatile LAS unsigned* st;
};

__device__ __forceinline__ XcdBarrier xcd_barrier_post(unsigned* bar, volatile LAS unsigned* st) {
    XcdBarrier b; b.bar = bar; b.x = xb_xcc_id(); b.st = st;
    if (threadIdx.x == 0) (void)xb_add(&bar[XB_XCNT(b.x)], 1u);
    return b;
}
__device__ __forceinline__ void xcd_barrier_complete(unsigned* bar, unsigned x, unsigned& nloc, unsigned& nx) {
    const unsigned G = gridDim.x * gridDim.y * gridDim.z;
    unsigned sum, cnt, mine, sp = 0u;
    for (;;) {
        sum = 0u; cnt = 0u; mine = 0u;
#pragma unroll
        for (unsigned j = 0; j < 16; ++j) { const unsigned c = xb_ld(&bar[XB_XCNT(j)]); sum += c; cnt += (c > 0u) ? 1u : 0u; mine = (j == x) ? c : mine; }
        if (sum == G) break;
        __builtin_amdgcn_s_sleep(1);
        if ((++sp & 255u) == 0u) { if (xb_ld(&bar[XB_TMO])) break; if (sp > XB_SPIN_CAP) { atomicAdd(&bar[XB_TMO], 1u); break; } }
    }
    nloc = mine > 0u ? mine : 1u; nx = cnt > 0u ? cnt : 1u;
}

__device__ __forceinline__ void xcd_barrier(const XcdBarrier& b) {
    asm volatile("s_waitcnt vmcnt(0)" ::: "memory");
    __syncthreads();
    if (threadIdx.x == 0) {
        unsigned* bar = b.bar;
        __builtin_amdgcn_s_waitcnt(0);
        unsigned nloc = b.st[0], nx = b.st[1];
        if (nloc == 0u) { xcd_barrier_complete(bar, b.x, nloc, nx); b.st[0] = nloc; b.st[1] = nx; }
        const unsigned old = xb_add(&bar[XB_XSUB(b.x)], 1u);
        const unsigned gen = old / nloc;
        if (old + 1u == (gen + 1u) * nloc) {
            __builtin_amdgcn_fence(__ATOMIC_RELEASE, "agent");
            asm volatile("s_waitcnt vmcnt(0)" ::: "memory");
            const unsigned og = xb_add(&bar[XB_TOP], 1u);
            const unsigned tg = og / nx;
            if (og + 1u == (tg + 1u) * nx) xb_add(&bar[XB_TOPGEN], 1u);
            else XB_SPIN(xb_ld(&bar[XB_TOPGEN]) == tg, bar);
            __builtin_amdgcn_fence(__ATOMIC_ACQUIRE, "agent");
            xb_add(&bar[XB_XGEN(b.x)], 1u);
            asm volatile("s_waitcnt vmcnt(0)" ::: "memory");
        } else {
            XB_SPIN(xb_ld(&bar[XB_XGEN(b.x)]) == gen, bar);
            __builtin_amdgcn_fence(__ATOMIC_ACQUIRE, "agent");
            asm volatile("s_waitcnt vmcnt(0)" ::: "memory");
        }
    }
    __syncthreads();
}


constexpr size_t WS_BAR = 200 * 1024;
__device__ __forceinline__ void grid_barrier(unsigned* bar, unsigned& gen) {
    asm volatile("s_waitcnt vmcnt(0) lgkmcnt(0)" ::: "memory");
    __syncthreads();
    ++gen;
    if (threadIdx.x == 0) {
        __builtin_amdgcn_fence(__ATOMIC_RELEASE, "agent");
        asm volatile("s_waitcnt vmcnt(0)" ::: "memory");
        const unsigned target = gen * gridDim.x;
        __hip_atomic_fetch_add(bar, 1u, __ATOMIC_RELAXED, __HIP_MEMORY_SCOPE_AGENT);
        while (__hip_atomic_load(bar, __ATOMIC_RELAXED, __HIP_MEMORY_SCOPE_AGENT) < target) __builtin_amdgcn_s_sleep(1);
        __builtin_amdgcn_fence(__ATOMIC_ACQUIRE, "agent");
        asm volatile("s_waitcnt vmcnt(0)" ::: "memory");
    }
    __syncthreads();
}

__global__ void __launch_bounds__(512, 2) fwd_megakernel(Args a_in) {
    extern __shared__ __attribute__((aligned(16))) unsigned char lds_raw[];
    LAS unsigned char* L = (LAS unsigned char*)lds_raw;
    cg::grid_group grid = cg::this_grid();
    const int G = gridDim.x, c = blockIdx.x;
    if (gridDim.y == 0x7fffu) grid.sync();
    unsigned* bar; { const Args a = kargs(); bar = (unsigned*)(a.ws + WS_BAR); }
    unsigned gen = 0; (void)gen;
    volatile LAS unsigned* xst = (volatile LAS unsigned*)(L + LDS_BYTES - 64);
    if (threadIdx.x == 0) { xst[0] = 0u; xst[1] = 0u; }
    __syncthreads();
    const XcdBarrier xbar = xcd_barrier_post(bar, xst);
#define GRID_SYNC() xcd_barrier(xbar)

    phase0(L);
#if defined(DUP_P01)
    GRID_SYNC();
    phase1();
    GRID_SYNC();
    phase0(L);
#endif
    GRID_SYNC();
#if defined(STOP_AFTER)
    if (STOP_AFTER == 1) return;
#endif
    phase1();
    GRID_SYNC();
#if defined(STOP_AFTER)
    if (STOP_AFTER == 2) return;
#endif
    {
        const Args a = kargs(); unsigned char* ws = a.ws;
        pg8::Gemm g{(const bf16_t*)(ws + WS_H), (const bf16_t*)(ws + WS_WIN), M_PAD, NT1 * 256, 1024}; pg8::StaticOrder S; S.init(M_PAD, NT1 * 256, G, c);
        EpiIn1 E{(bf16_t*)(ws + WS_Q), (bf16_t*)(ws + WS_K), (bf16_t*)(ws + WS_V), (bf16_t*)(ws + WS_ZA), (unsigned char*)a.out, a.out, a.in[12], a.in[13]};
        pg8::gemm_phase<EpiIn1, pg8::StaticOrder, true, true>(L, g, S, E);
#if defined(DUP_P2)
        __syncthreads();
        pg8::gemm_phase<EpiIn1, pg8::StaticOrder, true, true>(L, g, S, E);
#endif
    }
    GRID_SYNC();
#if defined(STOP_AFTER)
    if (STOP_AFTER == 3) return;
#endif
#if defined(DUP_ATTN)
    attn_phase<true>(L);
#endif
    attn_phase<false>(L);
    GRID_SYNC();
#if defined(STOP_AFTER)
    if (STOP_AFTER == 4) return;
#endif
    {
        const Args a = kargs(); unsigned char* ws = a.ws;
        pg8::Gemm g{(const bf16_t*)(ws + WS_H), (const bf16_t*)(ws + WS_WIN) + (size_t)NT1 * 256 * 1024, M_PAD, NT2 * 256, 1024}; pg8::StaticOrder S; S.init(M_PAD, NT2 * 256, G, c);
        EpiIn2 E{(bf16_t*)(ws + WS_ZS), (bf16_t*)(ws + WS_XBC), (bf16_t*)(ws + WS_HALO), (float*)(ws + WS_DT), a.out, a.in[18]};
        pg8::gemm_phase<EpiIn2, pg8::StaticOrder, true, true>(L, g, S, E);
#if defined(DUP_P4)
        __syncthreads();
        pg8::gemm_phase<EpiIn2, pg8::StaticOrder, true, true>(L, g, S, E);
#endif
    }
    GRID_SYNC();
#if defined(STOP_AFTER)
    if (STOP_AFTER == 5) return;
#endif
    conv_phase();
    GRID_SYNC();
#if defined(STOP_AFTER)
    if (STOP_AFTER == 6) return;
#endif
#if defined(DUP_SCAN)
    scan_phase<true>(L);
#endif
    scan_phase<false>(L);
    GRID_SYNC();
#if defined(DUP_FIX)
    scanfix_phase<true>(L);
#endif
    scanfix_phase<false>(L);
    GRID_SYNC();
#if defined(STOP_AFTER)
    if (STOP_AFTER == 7) return;
#endif
    ynorm_phase();
    {
        const Args a = kargs(); unsigned char* ws = a.ws;
        pg8::Gemm g{(const bf16_t*)(ws + WS_Q), (const bf16_t*)(ws + WS_WATT), T_P, 1024, 1024}; pg8::StaticOrder S; S.init(T_P, 1024, G, c);
        EpiA E{(bf16_t*)(ws + WS_H), (const unsigned char*)a.out};
        pg8::gemm_phase<EpiA, pg8::StaticOrder, true, true>(L, g, S, E);
        mini_gemm<0>((const bf16_t*)(ws + WS_Q), (const bf16_t*)(ws + WS_WATT), 1024, (bf16_t*)(ws + WS_H), (const unsigned char*)a.out, nullptr, nullptr, nullptr);
    }
    GRID_SYNC();
#if defined(STOP_AFTER)
    if (STOP_AFTER == 8) return;
#endif
    {
        const Args a = kargs(); unsigned char* ws = a.ws;
        pg8::Gemm g{(const bf16_t*)(ws + WS_ZS), (const bf16_t*)(ws + WS_WSSD), T_P, 1024, 2048}; pg8::StaticOrder S; S.init(T_P, 1024, G, c);
        EpiB E{(bf16_t*)(ws + WS_H), (const unsigned char*)a.out};
        pg8::gemm_phase<EpiB, pg8::StaticOrder, true, true>(L, g, S, E);
        mini_gemm<1>((const bf16_t*)(ws + WS_ZS), (const bf16_t*)(ws + WS_WSSD), 2048, (bf16_t*)(ws + WS_H), (const unsigned char*)a.out, nullptr, nullptr, nullptr);
    }
    GRID_SYNC();
#if defined(STOP_AFTER)
    if (STOP_AFTER == 9) return;
#endif
    {
        const Args a = kargs(); unsigned char* ws = a.ws;
        pg8::Gemm g{(const bf16_t*)(ws + WS_H), (const bf16_t*)(ws + WS_WOUT), T_P, 1024, 1024}; pg8::StaticOrder S; S.init(T_P, 1024, G, c);
        EpiOut E{a.out, a.in[0], a.in[1], (const float*)(ws + WS_MOD)};
        pg8::gemm_phase<EpiOut, pg8::StaticOrder, true, true>(L, g, S, E);
        mini_gemm<2>((const bf16_t*)(ws + WS_H), (const bf16_t*)(ws + WS_WOUT), 1024, nullptr, nullptr, a.out, a.in[1], (const float*)(ws + WS_MOD));
    }
}

extern "C" void kernel_launch(void* const* d_in, const int* in_sizes, int n_in, void* d_out, int out_size, void* d_ws, size_t ws_size, hipStream_t stream) {
    static int grid = 0;
    if (grid == 0) {
        if (n_in != 24 || (size_t)out_size != O_END || ws_size < WS_END) { fprintf(stderr, "kernel_launch: unexpected shapes (n_in %d out %d ws %zu)\n", n_in, out_size, ws_size); grid = -1; return; }
        int dev = 0, cus = 0, per_cu = 0;
        hipGetDevice(&dev); hipDeviceGetAttribute(&cus, hipDeviceAttributeMultiprocessorCount, dev);
        if (hipFuncSetAttribute((const void*)fwd_megakernel, hipFuncAttributeMaxDynamicSharedMemorySize, LDS_BYTES) != hipSuccess) { fprintf(stderr, "kernel_launch: hipFuncSetAttribute failed\n"); grid = -1; return; }
        if (hipOccupancyMaxActiveBlocksPerMultiprocessor(&per_cu, (const void*)fwd_megakernel, 512, LDS_BYTES) != hipSuccess || per_cu < 1) per_cu = 1;
        (void)hipGetLastError();
        grid = cus * per_cu;
    }
    if (grid < 0) return;
    if (hipMemsetAsync((char*)d_ws + WS_BAR, 0, 16384, stream) != hipSuccess) { fprintf(stderr, "kernel_launch: memset failed\n"); return; }
    Args a{};
    for (int i = 0; i < 24; ++i) a.in[i] = (const float*)d_in[i];
    a.out = (float*)d_out; a.ws = (unsigned char*)d_ws;
    void* args[] = {&a};
    hipError_t e = hipLaunchCooperativeKernel((const void*)fwd_megakernel, dim3(grid), dim3(512), args, LDS_BYTES, stream);
    if (e != hipSuccess) fprintf(stderr, "cooperative launch failed: %s (grid %d)\n", hipGetErrorString(e), grid);
}
```

```cpp
#include <hip/hip_runtime.h>
#include <hip/hip_cooperative_groups.h>
#include <cstdio>
#include <cstdint>
namespace cg = cooperative_groups;

#define LAS __attribute__((address_space(3)))
typedef unsigned short bf16_t;
typedef short bf16x8 __attribute__((ext_vector_type(8)));
typedef float f32x4 __attribute__((ext_vector_type(4)));
typedef float f32x2 __attribute__((ext_vector_type(2)));
typedef unsigned u32x4 __attribute__((ext_vector_type(4)));
typedef unsigned u32x2 __attribute__((ext_vector_type(2)));

constexpr int DM = 1024, T_P = 32768, T_S = 128, T_ALL = T_P + T_S, M_PAD = 33024;
constexpr int SEQ = 8192, NB = 4, NSB = 8, TS = 16;
constexpr int N_IN = 11296, NT1 = 24, NT2 = 21, N_WIN = (NT1 + NT2) * 256;
constexpr int CONVC = 3072, SSDW = 2048;
constexpr float EPS = 1e-6f, LOG2E = 1.4426950408889634f, QSCALE = 0.125f * 1.4426950408889634f;
constexpr size_t O_YP = 0, O_YS = O_YP + (size_t)T_P * DM, O_KP = O_YS + (size_t)T_S * DM, O_VP = O_KP + (size_t)NB * 512 * 1024,
                 O_CP = O_VP + (size_t)NB * 512 * 1024, O_HP = O_CP + (size_t)NB * 3 * CONVC, O_KS = O_HP + (size_t)NB * 32 * 64 * 128,
                 O_VS = O_KS + (size_t)T_S * 1024, O_CS = O_VS + (size_t)T_S * 1024, O_HS = O_CS + (size_t)NSB * 3 * CONVC,
                 O_END = O_HS + (size_t)NSB * 32 * 64 * 128;
constexpr size_t MiB = 1u << 20;
constexpr size_t WS_MOD = 0, WS_SSQ = 256 * 1024, WS_WIN = 1 * MiB, WS_WATT = 24 * MiB, WS_WSSD = 26 * MiB, WS_WOUT = 30 * MiB,
                 WS_HALO = 32 * MiB, WS_XBCS = 42 * MiB, WS_H = 43 * MiB, ROWB = (size_t)M_PAD * 1024 * 2  ,
                 WS_Q = WS_H + ROWB, WS_R = WS_Q + ROWB, WS_K = WS_R, WS_V = WS_R + ROWB, WS_ZA = WS_R + 2 * ROWB, WS_XBC = WS_R,
                 WS_ZS = WS_R + 3 * ROWB, WS_DT = WS_ZS + 2 * ROWB, WS_SSQP = WS_DT + (size_t)M_PAD * 32 * 4  , WS_SSQS = WS_SSQP + (size_t)32 * T_P * 4  , WS_END = WS_SSQS + (size_t)NSB * 32 * 32 * 4;
constexpr size_t WS_SST0 = WS_HALO, WS_SST1 = WS_HALO + 4 * MiB, WS_ACUM = WS_HALO + 8 * MiB, WS_ATOT = WS_SSQ;
static_assert(WS_END <= 512 * MiB, "workspace map");
static_assert(WS_SSQ + (size_t)T_ALL * 16 <= WS_WIN && WS_WIN + (size_t)N_WIN * 1024 * 2 <= WS_WATT, "ws map");
constexpr int LDS_BYTES = 147456;

typedef __bf16 bf16x2_t __attribute__((ext_vector_type(2)));
__device__ __forceinline__ unsigned cvt_pk_bf16(float lo, float hi) { const f32x2 v = {lo, hi}; const bf16x2_t b = __builtin_convertvector(v, bf16x2_t); return __builtin_bit_cast(unsigned, b); }
__device__ __forceinline__ void store16_wt(void* p, u32x4 v) { asm volatile("global_store_dwordx4 %0, %1, off sc0 sc1" :: "v"(p), "v"(v) : "memory"); }
__device__ __forceinline__ int tid_opaque() { int t = threadIdx.x; asm volatile("" : "+v"(t)); return t; }
__device__ __forceinline__ float bf_lo(unsigned w) { return __uint_as_float(w << 16); }
__device__ __forceinline__ float bf_hi(unsigned w) { return __uint_as_float(w & 0xffff0000u); }
__device__ __forceinline__ float silu_f(float x) { return x * __builtin_amdgcn_rcpf(1.f + __expf(-x)); }
__device__ __forceinline__ float sigmoid_f(float x) { return __builtin_amdgcn_rcpf(1.f + __expf(-x)); }
__device__ __forceinline__ f32x4 mfma16(bf16x8 a, bf16x8 b, f32x4 c) { return __builtin_amdgcn_mfma_f32_16x16x32_bf16(a, b, c, 0, 0, 0); }
__device__ __forceinline__ u32x4 pack8(const float* v) { u32x4 w; w.x = cvt_pk_bf16(v[0], v[1]); w.y = cvt_pk_bf16(v[2], v[3]); w.z = cvt_pk_bf16(v[4], v[5]); w.w = cvt_pk_bf16(v[6], v[7]); return w; }
__device__ __forceinline__ unsigned pk16(const u32x4& a, const u32x4& b, int dd) {
    const unsigned wa = (dd >> 1) == 0 ? a.x : (dd >> 1) == 1 ? a.y : (dd >> 1) == 2 ? a.z : a.w, wb = (dd >> 1) == 0 ? b.x : (dd >> 1) == 1 ? b.y : (dd >> 1) == 2 ? b.z : b.w;
    return (dd & 1) ? __builtin_amdgcn_perm(wb, wa, 0x07060302u) : __builtin_amdgcn_perm(wb, wa, 0x05040100u);
}
__device__ __forceinline__ unsigned el16(const u32x4& v, int dd) { const unsigned w = (dd >> 1) == 0 ? v.x : (dd >> 1) == 1 ? v.y : (dd >> 1) == 2 ? v.z : v.w; return (dd & 1) ? (w >> 16) : (w & 0xffffu); }

namespace pg8 {
#define PG8_LAS __attribute__((address_space(3)))
constexpr int BM = 256, BK = 64, HALF = 128, HTB = HALF * BK * 2, STAGE_BYTES = 8 * HTB, NXCD = 8, WGM = 4;
__host__ __device__ __forceinline__ int lds_byte(int r, int c) { const int st = (r >> 4) * 2 + (c >> 5), rr = r & 15, cc = c & 31, ob = rr * 64 + cc * 2; return st * 1024 + (ob ^ (((ob >> 9) & 1) << 5)); }
__host__ __device__ __forceinline__ void stage_rc(int b, int& R, int& C) { const int st = b / 1024, sb = b % 1024, swz = sb ^ (((sb >> 9) & 1) << 5); R = (st >> 1) * 16 + swz / 64; C = (st & 1) * 32 + (swz % 64) / 2; }
__host__ __device__ __forceinline__ int perm32(int rho) { const int n = rho >> 4, i = rho & 15; return 8 * (i >> 2) + 4 * n + (i & 3); }
struct Unit { int pm, pn; };
struct Gemm { const bf16_t* A; const bf16_t* Bt; int M, N, K; };
struct StaticOrder {
    int nM, nN, nwg, G, c;
    __host__ __device__ void init(int M, int N, int G_, int c_) { nM = M / BM; nN = N / BM; nwg = nM * nN; G = G_; c = c_; }
    __host__ __device__ bool next(int i, Unit& u) const {
        const long L = (long)i * G + c; if (L >= nwg) return false;
        int wgid = (int)L; { const int q = nwg / NXCD, r = nwg % NXCD, xcd = wgid % NXCD, off = wgid / NXCD; wgid = (xcd < r ? xcd * (q + 1) : r * (q + 1) + (xcd - r) * q) + off; }
        const int nig = WGM * nN, gid = wgid / nig, fm = gid * WGM, gsz = (nM - fm) < WGM ? (nM - fm) : WGM;
        u.pm = fm + ((wgid % nig) % gsz); u.pn = (wgid % nig) / gsz; return true;
    }
    __device__ __forceinline__ void a_ready(const Unit&) const {}
    __device__ __forceinline__ void done(const Unit&) const {}
};
template <class Epi, class Sched, bool ALIGN_EPI = false, bool SP2 = false>
__device__ __forceinline__ void gemm_phase(PG8_LAS unsigned char* lds, const Gemm g, const Sched& S, const Epi& E) {
    int tid_ = threadIdx.x; asm volatile("" : "+v"(tid_));
    const int tid = tid_, wid = __builtin_amdgcn_readfirstlane(tid >> 6), lane = tid & 63, wr = wid >> 2, wc = wid & 3, fr = lane & 15, fq = lane >> 4;
    const int K = g.K, nt = K / BK;
    unsigned voffA[2], voffB[2];
#pragma unroll
    for (int i = 0; i < 2; ++i) { int R, C; stage_rc(tid * 16 + i * 8192, R, C); const int Rb = Epi::PERM ? ((R & ~31) + perm32(R & 31)) : R;
        voffA[i] = (unsigned)(R * K + C) * 2u; voffB[i] = (unsigned)(Rb * K + C) * 2u; }
    const size_t kstep = (size_t)(BK * 2);
    const size_t hstep = (size_t)HALF * K * 2;
    const size_t tstep = 2 * hstep;
    const unsigned ldsw = (unsigned)wid * 1024u;
    const int aoff = lds_byte(wr * 64 + fr, fq * 8), boff = lds_byte(wc * 32 + fr, fq * 8);
#define PG8_SA(b, h) (((b) * 2 + (h)) * HTB)
#define PG8_SB(b, h) ((4 + (b) * 2 + (h)) * HTB)
#define PG8_STAGE(bufoff, gbase, voff) do { _Pragma("unroll") for (int _i = 0; _i < 2; ++_i) \
        __builtin_amdgcn_global_load_lds((const unsigned*)((const char*)(gbase) + (voff)[_i]), (PG8_LAS unsigned*)(lds + (bufoff) + ldsw + _i * 8192), 16, 0, 0); } while (0)
#define PG8_LDA(dst, b, h) do { _Pragma("unroll") for (int m = 0; m < 4; ++m) _Pragma("unroll") for (int k = 0; k < 2; ++k) dst[m][k] = *(const PG8_LAS bf16x8*)(lds + PG8_SA(b, h) + aoff + m * 2048 + k * 1024); } while (0)
#define PG8_LDB(dst, b, h) do { _Pragma("unroll") for (int n = 0; n < 2; ++n) _Pragma("unroll") for (int k = 0; k < 2; ++k) dst[n][k] = *(const PG8_LAS bf16x8*)(lds + PG8_SB(b, h) + boff + n * 2048 + k * 1024); } while (0)
#define PG8_MMA(ai, bj, At, Bt) do { __builtin_amdgcn_s_setprio(1); _Pragma("unroll") for (int m = 0; m < 4; ++m) _Pragma("unroll") for (int n = 0; n < 2; ++n) _Pragma("unroll") for (int k = 0; k < 2; ++k) \
        acc[ai][bj][m][n] = __builtin_amdgcn_mfma_f32_16x16x32_bf16(Bt[n][k], At[m][k], acc[ai][bj][m][n], 0, 0, 0); __builtin_amdgcn_s_setprio(0); } while (0)
#define PG8_WAIT_V(n) asm volatile("s_waitcnt vmcnt(" #n ")" ::: "memory")
#define PG8_WAIT_L(n) asm volatile("s_waitcnt lgkmcnt(" #n ")" ::: "memory")
#define PG8_BAR __builtin_amdgcn_s_barrier()
#define PG8_SCHED __builtin_amdgcn_sched_barrier(0)
    Unit cur, nxt; int ui = 0;
    if (!S.next(0, cur)) return;
    f32x4 acc[2][2][4][2];
#pragma unroll
    for (int a = 0; a < 2; ++a)
#pragma unroll
        for (int b = 0; b < 2; ++b)
#pragma unroll
            for (int m = 0; m < 4; ++m)
#pragma unroll
                for (int n = 0; n < 2; ++n) acc[a][b][m][n] = (f32x4){0.f, 0.f, 0.f, 0.f};
    bf16x8 At[4][2], B0[2][2], B1[2][2];
    const char* cA = (const char*)g.A + (size_t)cur.pm * tstep; const char* cB = (const char*)g.Bt + (size_t)cur.pn * tstep;
    S.a_ready(cur);
    if constexpr (SP2) {
        PG8_STAGE(PG8_SB(0, 0), cB, voffB); PG8_STAGE(PG8_SB(0, 1), cB + hstep, voffB); PG8_STAGE(PG8_SA(0, 0), cA, voffA); PG8_STAGE(PG8_SA(0, 1), cA + hstep, voffA);
        if (wr == 1) PG8_BAR;
        PG8_WAIT_V(2); PG8_BAR;
        PG8_STAGE(PG8_SB(1, 0), cB + kstep, voffB); PG8_STAGE(PG8_SA(1, 0), cA + kstep, voffA); PG8_STAGE(PG8_SB(1, 1), cB + hstep + kstep, voffB);
        PG8_WAIT_V(6); PG8_BAR;
    } else {
        PG8_STAGE(PG8_SB(0, 0), cB, voffB); PG8_STAGE(PG8_SA(0, 0), cA, voffA); PG8_STAGE(PG8_SB(0, 1), cB + hstep, voffB); PG8_STAGE(PG8_SA(0, 1), cA + hstep, voffA);
        if (wr == 1) PG8_BAR;
        PG8_WAIT_V(4); PG8_BAR;
        PG8_STAGE(PG8_SB(1, 0), cB + kstep, voffB); PG8_STAGE(PG8_SA(1, 0), cA + kstep, voffA); PG8_STAGE(PG8_SB(1, 1), cB + hstep + kstep, voffB);
        PG8_WAIT_V(6); PG8_BAR;
    }
    for (;;) {
        const bool has_next = S.next(ui + 1, nxt);
        const char* nA = has_next ? (const char*)g.A + (size_t)nxt.pm * tstep : cA; const char* nB = has_next ? (const char*)g.Bt + (size_t)nxt.pn * tstep : cB;
        for (int t = 0; t < nt; t += 2) {
            const bool last = (t == nt - 2);
            const char* a1 = cA + (size_t)(t + 1) * kstep;
            const char* a2 = last ? nA : cA + (size_t)(t + 2) * kstep; const char* b2 = last ? nB : cB + (size_t)(t + 2) * kstep;
            const char* a3 = a2 + kstep; const char* b3 = b2 + kstep;
            if (last && has_next) S.a_ready(nxt);
            if constexpr (SP2) {
            PG8_LDB(B0, 0, 0); PG8_LDB(B1, 0, 1); PG8_SCHED; PG8_LDA(At, 0, 0); PG8_STAGE(PG8_SA(1, 1), a1 + hstep, voffA);
            PG8_WAIT_V(8); PG8_WAIT_L(0); PG8_BAR; PG8_MMA(0, 0, At, B0); PG8_MMA(0, 1, At, B1); PG8_BAR; PG8_SCHED;
            PG8_LDA(At, 0, 1); PG8_STAGE(PG8_SB(0, 0), b2, voffB); PG8_STAGE(PG8_SB(0, 1), b2 + hstep, voffB); PG8_STAGE(PG8_SA(0, 0), a2, voffA);
            PG8_WAIT_V(8); PG8_WAIT_L(0); PG8_BAR; PG8_MMA(1, 0, At, B0); PG8_MMA(1, 1, At, B1); PG8_BAR; PG8_SCHED;
            PG8_LDB(B0, 1, 0); PG8_LDB(B1, 1, 1); PG8_SCHED; PG8_LDA(At, 1, 0); PG8_STAGE(PG8_SA(0, 1), a2 + hstep, voffA);
            PG8_WAIT_V(8); PG8_WAIT_L(0); PG8_BAR; PG8_MMA(0, 0, At, B0); PG8_MMA(0, 1, At, B1); PG8_BAR; PG8_SCHED;
            PG8_LDA(At, 1, 1); PG8_STAGE(PG8_SB(1, 0), b3, voffB); PG8_STAGE(PG8_SB(1, 1), b3 + hstep, voffB); PG8_STAGE(PG8_SA(1, 0), a3, voffA);
            PG8_WAIT_V(8); PG8_WAIT_L(0); PG8_BAR; PG8_MMA(1, 0, At, B0); PG8_MMA(1, 1, At, B1); PG8_BAR; PG8_SCHED;
            } else {
            PG8_LDB(B0, 0, 0); PG8_SCHED; PG8_LDA(At, 0, 0); PG8_STAGE(PG8_SA(1, 1), a1 + hstep, voffA);
            PG8_WAIT_L(8); PG8_BAR; PG8_WAIT_L(0); PG8_MMA(0, 0, At, B0); PG8_BAR; PG8_SCHED;
            PG8_LDB(B1, 0, 1); PG8_STAGE(PG8_SB(0, 0), b2, voffB);
            PG8_BAR; PG8_WAIT_L(0); PG8_MMA(0, 1, At, B1); PG8_BAR;
            PG8_LDA(At, 0, 1); PG8_STAGE(PG8_SA(0, 0), a2, voffA);
            PG8_BAR; PG8_WAIT_L(0); PG8_MMA(1, 0, At, B0); PG8_BAR; PG8_SCHED;
            PG8_STAGE(PG8_SB(0, 1), b2 + hstep, voffB);
            PG8_WAIT_V(6); PG8_BAR; PG8_MMA(1, 1, At, B1); PG8_BAR;
            PG8_LDB(B0, 1, 0); PG8_SCHED; PG8_LDA(At, 1, 0); PG8_STAGE(PG8_SA(0, 1), a2 + hstep, voffA);
            PG8_WAIT_L(8); PG8_BAR; PG8_WAIT_L(0); PG8_MMA(0, 0, At, B0); PG8_BAR; PG8_SCHED;
            PG8_LDB(B1, 1, 1); PG8_STAGE(PG8_SB(1, 0), b3, voffB);
            PG8_BAR; PG8_WAIT_L(0); PG8_MMA(0, 1, At, B1); PG8_BAR;
            PG8_LDA(At, 1, 1); PG8_STAGE(PG8_SA(1, 0), a3, voffA);
            PG8_BAR; PG8_WAIT_L(0); PG8_MMA(1, 0, At, B0); PG8_BAR; PG8_SCHED;
            PG8_STAGE(PG8_SB(1, 1), b3 + hstep, voffB);
            PG8_WAIT_V(6); PG8_BAR; PG8_MMA(1, 1, At, B1); PG8_BAR;
            }
        }
        if constexpr (ALIGN_EPI) { if (wr == 0) PG8_BAR; }
        E(acc, cur, wr, wc, fr, fq); S.done(cur);
        if (!has_next) break;
#pragma unroll
        for (int a = 0; a < 2; ++a)
#pragma unroll
            for (int b = 0; b < 2; ++b)
#pragma unroll
                for (int m = 0; m < 4; ++m)
#pragma unroll
                    for (int n = 0; n < 2; ++n) acc[a][b][m][n] = (f32x4){0.f, 0.f, 0.f, 0.f};
        cur = nxt; cA = nA; cB = nB; ++ui;
        if constexpr (ALIGN_EPI) { if (wr == 1) PG8_BAR; }
    }
    PG8_WAIT_V(0);
    if constexpr (!ALIGN_EPI) { if (wr == 0) PG8_BAR; }
    PG8_BAR;
#undef PG8_SA
#undef PG8_SB
#undef PG8_STAGE
#undef PG8_LDA
#undef PG8_LDB
#undef PG8_MMA
#undef PG8_WAIT_V
#undef PG8_WAIT_L
#undef PG8_BAR
#undef PG8_SCHED
}
}
using pg8::Unit;

#define EPI_ROW(u, ai, wr, m, fr) ((u).pm * 256 + (ai) * 128 + (wr) * 64 + (m) * 16 + (fr))

struct EpiIn1 {
    static constexpr bool PERM = true, AFTER_DRAIN = false;
    bf16_t *Q, *K, *V, *ZA; unsigned char* gates; float* out; const float *qg, *kg;
    __device__ __forceinline__ void operator()(const f32x4 (&acc)[2][2][4][2], const Unit& u, int wr, int wc, int fr, int fq) const {
        const int pn = u.pn, seg = pn >> 2;
        if (seg <= 1) {
            const float* gv = seg == 0 ? qg : kg; const float sc = seg == 0 ? QSCALE : 1.f;
            float g[2][8];
#pragma unroll
            for (int bj = 0; bj < 2; ++bj)
#pragma unroll
                for (int e = 0; e < 8; ++e) g[bj][e] = gv[32 * bj + 8 * fq + e] * sc;
            const int colbase = (pn & 3) * 256 + 64 * wc + 8 * fq;
            bf16_t* dstb = seg == 0 ? Q : K;
#pragma unroll
            for (int ai = 0; ai < 2; ++ai)
#pragma unroll
                for (int m = 0; m < 4; ++m) {
                    float ss = 0.f;
#pragma unroll
                    for (int bj = 0; bj < 2; ++bj)
#pragma unroll
                        for (int n = 0; n < 2; ++n) { const f32x4 v = acc[ai][bj][m][n]; ss += (v[0] * v[0] + v[1] * v[1]) + (v[2] * v[2] + v[3] * v[3]); }
                    ss += __shfl_xor(ss, 16); ss += __shfl_xor(ss, 32);
                    const float rinv = rsqrtf(ss * (1.f / 64.f) + EPS);
                    const int row = EPI_ROW(u, ai, wr, m, fr);
#pragma unroll
                    for (int bj = 0; bj < 2; ++bj) {
                        float o[8];
#pragma unroll
                        for (int e = 0; e < 8; ++e) o[e] = acc[ai][bj][m][e >> 2][e & 3] * rinv * g[bj][e];
                        const int col = colbase + 32 * bj;
                        *(u32x4*)(dstb + (size_t)row * 1024 + col) = pack8(o);
                        if (seg == 1) {
                            float* d = nullptr;
                            if (row < T_P) { const int s = row & (SEQ - 1); if (s >= SEQ - 512) d = out + O_KP + ((size_t)((row >> 13) * 512 + s - (SEQ - 512)) * 1024 + col); }
                            else if (row < T_ALL) d = out + O_KS + ((size_t)(row - T_P) * 1024 + col);
                            if (d) { *(f32x4*)d = (f32x4){o[0], o[1], o[2], o[3]}; *(f32x4*)(d + 4) = (f32x4){o[4], o[5], o[6], o[7]}; }
                        }
                    }
                }
        } else if (seg <= 3) {
            const int colbase = (pn & 3) * 256 + 64 * wc + 8 * fq;
            bf16_t* dstb = seg == 2 ? V : ZA;
#pragma unroll
            for (int ai = 0; ai < 2; ++ai)
#pragma unroll
                for (int m = 0; m < 4; ++m) {
                    const int row = EPI_ROW(u, ai, wr, m, fr);
#pragma unroll
                    for (int bj = 0; bj < 2; ++bj) {
                        float o[8];
#pragma unroll
                        for (int e = 0; e < 8; ++e) { const float v = acc[ai][bj][m][e >> 2][e & 3]; o[e] = seg == 2 ? v : silu_f(v); }
                        const int col = colbase + 32 * bj;
                        *(u32x4*)(dstb + (size_t)row * 1024 + col) = pack8(o);
                        if (seg == 2) {
                            float* d = nullptr;
                            if (row < T_P) { const int s = row & (SEQ - 1); if (s >= SEQ - 512) d = out + O_VP + ((size_t)((row >> 13) * 512 + s - (SEQ - 512)) * 1024 + col); }
                            else if (row < T_ALL) d = out + O_VS + ((size_t)(row - T_P) * 1024 + col);
                            if (d) { *(f32x4*)d = (f32x4){o[0], o[1], o[2], o[3]}; *(f32x4*)(d + 4) = (f32x4){o[4], o[5], o[6], o[7]}; }
                        }
                    }
                }
        } else {
            const int colbase = (pn - 16) * 256 + 64 * wc + 8 * fq;
#pragma unroll
            for (int ai = 0; ai < 2; ++ai)
#pragma unroll
                for (int m = 0; m < 4; ++m) {
                    const int row = EPI_ROW(u, ai, wr, m, fr);
                    if (row < T_ALL) {
#pragma unroll
                        for (int bj = 0; bj < 2; ++bj) {
                            float o[8];
#pragma unroll
                            for (int e = 0; e < 8; ++e) o[e] = sigmoid_f(acc[ai][bj][m][e >> 2][e & 3]);
                            *(u32x4*)(gates + (size_t)row * 4096 + (size_t)(colbase + 32 * bj) * 2) = pack8(o);
                        }
                    }
                }
        }
    }
};

struct EpiIn2 {
    static constexpr bool PERM = true, AFTER_DRAIN = false;
    bf16_t *ZS, *XBC, *HALO; float* DT; float* out; const float* dt_bias;
    __device__ __forceinline__ void operator()(const f32x4 (&acc)[2][2][4][2], const Unit& u, int wr, int wc, int fr, int fq) const {
        const int pn = u.pn;
        if (pn < 8) {
            const int colbase = pn * 256 + 64 * wc + 8 * fq;
#pragma unroll
            for (int ai = 0; ai < 2; ++ai)
#pragma unroll
                for (int m = 0; m < 4; ++m) {
                    const int row = EPI_ROW(u, ai, wr, m, fr);
#pragma unroll
                    for (int bj = 0; bj < 2; ++bj) {
                        float o[8];
#pragma unroll
                        for (int e = 0; e < 8; ++e) o[e] = silu_f(acc[ai][bj][m][e >> 2][e & 3]);
                        *(u32x4*)(ZS + (size_t)row * SSDW + colbase + 32 * bj) = pack8(o);
                    }
                }
        } else if (pn < 20) {
            const int colbase = (pn - 8) * 256 + 64 * wc + 8 * fq;
#pragma unroll
            for (int ai = 0; ai < 2; ++ai)
#pragma unroll
                for (int m = 0; m < 4; ++m) {
                    const int row = EPI_ROW(u, ai, wr, m, fr);
#pragma unroll
                    for (int bj = 0; bj < 2; ++bj) {
                        float o[8];
#pragma unroll
                        for (int e = 0; e < 8; ++e) o[e] = acc[ai][bj][m][e >> 2][e & 3];
                        const int col = colbase + 32 * bj;
                        const u32x4 w = pack8(o);
                        *(u32x4*)(XBC + (size_t)row * CONVC + col) = w;
                        if (m == 3 && fr >= 13) {
                            *(u32x4*)(HALO + ((size_t)(row >> 6) * 3 + (fr - 13)) * CONVC + col) = w;
                            if (row < T_P && (row & (SEQ - 1)) >= SEQ - 3) {
                                float* d = out + O_CP + ((size_t)((row >> 13) * 3 + (fr - 13)) * CONVC + col);
                                *(f32x4*)d = (f32x4){o[0], o[1], o[2], o[3]}; *(f32x4*)(d + 4) = (f32x4){o[4], o[5], o[6], o[7]};
                            }
                        }
                        if (fr >= 13 && row >= T_P && row < T_ALL) {
                            float* d = out + O_CS + ((size_t)(((row - T_P) >> 4) * 3 + (fr - 13)) * CONVC + col);
                            *(f32x4*)d = (f32x4){o[0], o[1], o[2], o[3]}; *(f32x4*)(d + 4) = (f32x4){o[4], o[5], o[6], o[7]};
                        }
                    }
                }
        } else {
            if (wc == 0) {
                float bb[8];
#pragma unroll
                for (int e = 0; e < 8; ++e) bb[e] = dt_bias[8 * fq + e];
#pragma unroll
                for (int ai = 0; ai < 2; ++ai)
#pragma unroll
                    for (int m = 0; m < 4; ++m) {
                        const int row = EPI_ROW(u, ai, wr, m, fr);
                        float o[8];
#pragma unroll
                        for (int e = 0; e < 8; ++e) { const float v = acc[ai][0][m][e >> 2][e & 3] + bb[e]; o[e] = v > 20.f ? v : log1pf(__expf(v)); }
                        float* d = DT + (size_t)row * 32 + 8 * fq;
                        *(f32x4*)d = (f32x4){o[0], o[1], o[2], o[3]}; *(f32x4*)(d + 4) = (f32x4){o[4], o[5], o[6], o[7]};
                    }
            }
        }
    }
};

struct EpiA {
    static constexpr bool PERM = true, AFTER_DRAIN = false;
    bf16_t* Mo; const unsigned char* gates;
    __device__ __forceinline__ void operator()(const f32x4 (&acc)[2][2][4][2], const Unit& u, int wr, int wc, int fr, int fq) const {
        const int colbase = u.pn * 256 + 64 * wc + 8 * fq;
#pragma unroll
        for (int ai = 0; ai < 2; ++ai)
#pragma unroll
            for (int m = 0; m < 4; ++m) {
                const int row = EPI_ROW(u, ai, wr, m, fr);
#pragma unroll
                for (int bj = 0; bj < 2; ++bj) {
                    const int col = colbase + 32 * bj;
                    u32x4 gw = (u32x4){0u, 0u, 0u, 0u};
                    if (row < T_ALL) gw = *(const u32x4*)(gates + (size_t)row * 4096 + (size_t)col * 2);
                    const unsigned gws[4] = {gw.x, gw.y, gw.z, gw.w};
                    float o[8];
#pragma unroll
                    for (int e = 0; e < 8; ++e) { const float gg = (e & 1) ? bf_hi(gws[e >> 1]) : bf_lo(gws[e >> 1]); o[e] = gg * acc[ai][bj][m][e >> 2][e & 3]; }
                    *(u32x4*)(Mo + (size_t)row * 1024 + col) = pack8(o);
                }
            }
    }
};
struct EpiB {
    static constexpr bool PERM = true, AFTER_DRAIN = false;
    bf16_t* Mo; const unsigned char* gates;
    __device__ __forceinline__ void operator()(const f32x4 (&acc)[2][2][4][2], const Unit& u, int wr, int wc, int fr, int fq) const {
        const int colbase = u.pn * 256 + 64 * wc + 8 * fq;
#pragma unroll
        for (int ai = 0; ai < 2; ++ai)
#pragma unroll
            for (int m = 0; m < 4; ++m) {
                const int row = EPI_ROW(u, ai, wr, m, fr);
#pragma unroll
                for (int bj = 0; bj < 2; ++bj) {
                    const int col = colbase + 32 * bj;
                    u32x4 gw = (u32x4){0u, 0u, 0u, 0u};
                    if (row < T_ALL) gw = *(const u32x4*)(gates + (size_t)row * 4096 + (size_t)(1024 + col) * 2);
                    const u32x4 mw = *(const u32x4*)(Mo + (size_t)row * 1024 + col);
                    const unsigned gws[4] = {gw.x, gw.y, gw.z, gw.w}, mws[4] = {mw.x, mw.y, mw.z, mw.w};
                    float o[8];
#pragma unroll
                    for (int e = 0; e < 8; ++e) { const float gg = (e & 1) ? bf_hi(gws[e >> 1]) : bf_lo(gws[e >> 1]); const float mm = (e & 1) ? bf_hi(mws[e >> 1]) : bf_lo(mws[e >> 1]);
                        o[e] = mm + gg * acc[ai][bj][m][e >> 2][e & 3]; }
                    *(u32x4*)(Mo + (size_t)row * 1024 + col) = pack8(o);
                }
            }
    }
};
struct EpiOut {
    static constexpr bool PERM = true, AFTER_DRAIN = false;
    float* out; const float *xp, *xs; const float* mod;
    __device__ __forceinline__ void operator()(const f32x4 (&acc)[2][2][4][2], const Unit& u, int wr, int wc, int fr, int fq) const {
        const int colbase = u.pn * 256 + 64 * wc + 8 * fq;
#pragma unroll
        for (int ai = 0; ai < 2; ++ai)
#pragma unroll
            for (int m = 0; m < 4; ++m) {
                const int row = EPI_ROW(u, ai, wr, m, fr);
                if (row < T_ALL) {
                    const int r12 = row < T_P ? (row >> 13) : 4 + ((row - T_P) >> 4);
                    const float* xr = row < T_P ? xp + (size_t)row * 1024 : xs + (size_t)(row - T_P) * 1024;
#pragma unroll
                    for (int bj = 0; bj < 2; ++bj) {
                        const int col = colbase + 32 * bj;
#pragma unroll
                        for (int n = 0; n < 2; ++n) {
                            const f32x4 xv = *(const f32x4*)(xr + col + 4 * n);
                            const f32x4 gv = *(const f32x4*)(mod + (size_t)r12 * 3072 + 2048 + col + 4 * n);
                            *(f32x4*)(out + (size_t)row * 1024 + col + 4 * n) = xv + gv * acc[ai][bj][m][n];
                        }
                    }
                }
            }
    }
};

struct Args { const float* in[24]; float* out; unsigned char* ws; };
typedef const Args __attribute__((address_space(4)))* KArgsPtr;
__device__ __forceinline__ Args kargs() {
#if defined(__HIP_DEVICE_COMPILE__)
    KArgsPtr p = (KArgsPtr)__builtin_amdgcn_kernarg_segment_ptr(); asm volatile("" : "+s"(p));
    Args r; for (int i = 0; i < 24; ++i) r.in[i] = p->in[i]; r.out = p->out; r.ws = p->ws; return r;
#else
    return Args{};
#endif
}

__device__ __forceinline__ int win_src_col(int np) {
    const int T = np >> 8, p = np & 255;
    const int j = 64 * ((p >> 5) & 3) + 32 * (p >> 7) + (p & 31);
    if (T < 16) return T * 256 + j;
    if (T < 24) return 9248 + (T - 16) * 256 + j;
    if (T < 32) return 4096 + (T - 24) * 256 + j;
    if (T < 44) return 6144 + (T - 32) * 256 + j;
    return j < 32 ? 9216 + j : -1;
}
__device__ __forceinline__ int gen_src_col(int np) { const int p = np & 255; return (np & ~255) + 64 * ((p >> 5) & 3) + 32 * (p >> 7) + (p & 31); }

__device__ __forceinline__ void transpose_item(const float* W, int K, int Nsrc, bf16_t* WT, int np0, int src0, int k0, const float* kscale, LAS float* scr, int lane) {
    float vv[32];
#pragma unroll
    for (int i = 0; i < 32; ++i) { const int kk = 2 * i + (lane >> 5); vv[i] = 0.f;
        if (src0 >= 0) vv[i] = W[(size_t)(k0 + kk) * Nsrc + src0 + (lane & 31)]; }
#pragma unroll
    for (int i = 0; i < 32; ++i) { const int kk = 2 * i + (lane >> 5); float v = vv[i];
        if (src0 >= 0 && kscale) v *= kscale[k0 + kk];
        scr[kk * 33 + (lane & 31)] = v; }
    asm volatile("s_waitcnt lgkmcnt(0)" ::: "memory");
    const int c = lane & 7;
#pragma unroll
    for (int j = 0; j < 4; ++j) { const int n = (lane >> 3) + 8 * j; const LAS float* s = scr + (8 * c) * 33 + n;
        u32x4 o; o.x = cvt_pk_bf16(s[0 * 33], s[1 * 33]); o.y = cvt_pk_bf16(s[2 * 33], s[3 * 33]); o.z = cvt_pk_bf16(s[4 * 33], s[5 * 33]); o.w = cvt_pk_bf16(s[6 * 33], s[7 * 33]);
        *(u32x4*)(WT + (size_t)(np0 + n) * K + k0 + 8 * c) = o; }
    asm volatile("s_waitcnt lgkmcnt(0)" ::: "memory");
}

__device__ __forceinline__ void phase0(LAS unsigned char* L) {
    const Args a = kargs();
    const int tid = tid_opaque(), lane = tid & 63, wave = tid >> 6;
    unsigned char* ws = a.ws;
    float* mod = (float*)(ws + WS_MOD);
    if (blockIdx.x < 96) {
        LAS float* sc = (LAS float*)L; LAS float* red = (LAS float*)(L + 49152);
        for (int i = tid; i < 12 * 1024; i += 512) { const int r = i >> 10, k = i & 1023; const float c = r < 4 ? a.in[2][r * 1024 + k] : a.in[3][(r - 4) * 1024 + k]; sc[i] = silu_f(c); }
        __syncthreads();
        const float* w_ada = a.in[9]; const float* b_ada = a.in[10];
        for (int item = blockIdx.x; item < 96; item += gridDim.x) {
            const int cc = tid & 31, kq = tid >> 5, col = 32 * item + cc;
            float acc[12];
#pragma unroll
            for (int r = 0; r < 12; ++r) acc[r] = 0.f;
#pragma unroll 8
            for (int kk = 0; kk < 64; ++kk) { const int k = 64 * kq + kk; const float w = w_ada[(size_t)k * 3072 + col];
#pragma unroll
                for (int r = 0; r < 12; ++r) acc[r] += sc[r * 1024 + k] * w; }
#pragma unroll
            for (int r = 0; r < 12; ++r) red[(kq * 32 + cc) * 12 + r] = acc[r];
            __syncthreads();
            if (tid < 384) { const int c2 = tid / 12, r = tid % 12; float s = 0.f; for (int q = 0; q < 16; ++q) s += red[(q * 32 + c2) * 12 + r];
                mod[r * 3072 + 32 * item + c2] = s + b_ada[32 * item + c2]; }
            __syncthreads();
        }
    }
    __syncthreads();
    LAS float* scr = (LAS float*)(L + wave * 16384);
    const int gw = blockIdx.x * 8 + wave, NGW = gridDim.x * 8;
    constexpr int I_IN = 16 * (N_WIN / 32), I_ATT = 16 * 32, I_SSD = 32 * 32, I_OUT = 16 * 32;
    for (int it = gw; it < I_IN + I_ATT + I_SSD + I_OUT; it += NGW) {
        int r = it;
        if (r < I_IN) { const int kb = r / (N_WIN / 32), ng = r % (N_WIN / 32); transpose_item(a.in[11], 1024, N_IN, (bf16_t*)(ws + WS_WIN), 32 * ng, win_src_col(32 * ng), 64 * kb, nullptr, scr, lane); continue; } r -= I_IN;
        if (r < I_ATT) { const int kb = r / 32, ng = r % 32; transpose_item(a.in[15], 1024, 1024, (bf16_t*)(ws + WS_WATT), 32 * ng, gen_src_col(32 * ng), 64 * kb, nullptr, scr, lane); continue; } r -= I_ATT;
        if (r < I_SSD) { const int kb = r / 32, ng = r % 32; transpose_item(a.in[22], 2048, 1024, (bf16_t*)(ws + WS_WSSD), 32 * ng, gen_src_col(32 * ng), 64 * kb, a.in[21], scr, lane); continue; } r -= I_SSD;
        { const int kb = r / 32, ng = r % 32; transpose_item(a.in[23], 1024, 1024, (bf16_t*)(ws + WS_WOUT), 32 * ng, gen_src_col(32 * ng), 64 * kb, nullptr, scr, lane); }
    }
}

__device__ __forceinline__ void phase1() {
    const Args a = kargs();
    const int tid = tid_opaque(), lane = tid & 63, wave = tid >> 6;
    const float* mod = (const float*)(a.ws + WS_MOD); const float* ng = a.in[8];
    bf16_t* H = (bf16_t*)(a.ws + WS_H);
    const int gw = blockIdx.x * 8 + wave, NGW = gridDim.x * 8;
    for (int row = gw; row < M_PAD; row += NGW) {
        u32x2* o8 = (u32x2*)(H + (size_t)row * 1024) + lane;
        if (row >= T_ALL) {
#pragma unroll
            for (int j = 0; j < 4; ++j) o8[64 * j] = (u32x2){0u, 0u};
            continue;
        }
        const float* xr = row < T_P ? a.in[0] + (size_t)row * 1024 : a.in[1] + (size_t)(row - T_P) * 1024;
        const int r12 = row < T_P ? (row >> 13) : 4 + ((row - T_P) >> 4);
        const float* mr = mod + (size_t)r12 * 3072;
        f32x4 v[4]; float s = 0.f;
#pragma unroll
        for (int j = 0; j < 4; ++j) { v[j] = *((const f32x4*)xr + lane + 64 * j); s += (v[j][0] * v[j][0] + v[j][1] * v[j][1]) + (v[j][2] * v[j][2] + v[j][3] * v[j][3]); }
#pragma unroll
        for (int o = 1; o < 64; o <<= 1) s += __shfl_xor(s, o);
        const float rinv = rsqrtf(s * (1.f / 1024.f) + EPS);
#pragma unroll
        for (int j = 0; j < 4; ++j) {
            const int c = 4 * (lane + 64 * j);
            const f32x4 gv = *(const f32x4*)(ng + c), sh = *(const f32x4*)(mr + c), scl = *(const f32x4*)(mr + 1024 + c);
            const f32x4 h = v[j] * rinv * gv * (scl + 1.f) + sh;
            o8[64 * j] = (u32x2){cvt_pk_bf16(h[0], h[1]), cvt_pk_bf16(h[2], h[3])};
        }
    }
}

template <bool DUMMY> __device__ __forceinline__ void attn_phase(LAS unsigned char* L) {
    const Args a = kargs();
    const int tid = tid_opaque(), lane = tid & 63, wave = __builtin_amdgcn_readfirstlane(tid >> 6);
    const int r = lane & 15, qq = lane >> 4, hw = wave >> 2, qt = wave & 3;
    bf16_t* Qb = (bf16_t*)(a.ws + WS_Q); const bf16_t* Kb = (const bf16_t*)(a.ws + WS_K); const bf16_t* Vb = (const bf16_t*)(a.ws + WS_V);
    const bf16_t* ZA = (const bf16_t*)(a.ws + WS_ZA);
    const float* cache_k = a.in[4]; const float* cache_v = a.in[5]; const float* rel_bias = a.in[14];
    LAS float* tbl = (LAS float*)(L + 73728);
    constexpr int NPROMPT = NB * 8 * 32, NITEMS = NPROMPT + NSB * 8;
    int tbl_hp = -1;
    for (int id = blockIdx.x; id < NITEMS; id += gridDim.x) {
        const bool samp = id >= NPROMPT;
        int hp, c0, b, sb;
        if (!samp) { hp = id & 7; c0 = 4 * (31 - ((id >> 3) & 31)); b = id >> 8; sb = 0; } else { const int x = id - NPROMPT; hp = x & 7; sb = x >> 3; c0 = 8; b = 0; }
        const int head = 2 * hp + hw;
        if (hp != tbl_hp) {
            for (int i = tid; i < 1280; i += 512) { const int hh = i >= 640 ? 1 : 0, j = i - 640 * hh; int d = j - 63; d = d > 256 ? 256 : d; tbl[i] = rel_bias[(2 * hp + hh) * 513 + d + 256] * LOG2E; }
            tbl_hp = hp;
        }
        const bool wactive = !samp || qt == 0;
        bf16x8 qf[4][2];
#pragma unroll
        for (int cc = 0; cc < 4; ++cc) {
            const int qrow = samp ? T_P + 16 * sb + r : b * SEQ + 64 * (c0 + cc) + 16 * qt + r;
#pragma unroll
            for (int ks = 0; ks < 2; ++ks) qf[cc][ks] = (wactive && (!samp || cc == 0)) ? *(const bf16x8*)(Qb + (size_t)qrow * 1024 + 64 * head + 32 * ks + 8 * qq) : (bf16x8){0, 0, 0, 0, 0, 0, 0, 0};
        }
        const int jlo = samp ? 0 : (c0 >= 8 ? c0 - 8 : 0), jhi = samp ? 8 : c0 + 3;
        u32x4 pre[4];
        auto load_blk = [&](int j) {
            if (tid < 256) {
                const int c16 = tid & 15;
#pragma unroll
                for (int e = 0; e < 4; ++e) { const int key = (tid >> 4) + 16 * e;
                    if (!samp) pre[e] = *(const u32x4*)(Kb + (size_t)(b * SEQ + 64 * j + key) * 1024 + 128 * hp + 8 * c16);
                    else if (j < 8) { const float* s = cache_k + ((size_t)(sb * 512 + 64 * j + key) * 1024 + 128 * hp + 8 * c16); const f32x4 x0 = *(const f32x4*)s, x1 = *(const f32x4*)(s + 4);
                        pre[e] = (u32x4){cvt_pk_bf16(x0[0], x0[1]), cvt_pk_bf16(x0[2], x0[3]), cvt_pk_bf16(x1[0], x1[1]), cvt_pk_bf16(x1[2], x1[3])}; }
                    else pre[e] = key < 16 ? *(const u32x4*)(Kb + (size_t)(T_P + 16 * sb + key) * 1024 + 128 * hp + 8 * c16) : (u32x4){0u, 0u, 0u, 0u}; }
            } else {
                const int u = tid - 256, kg = u >> 4, c16 = u & 15;
#pragma unroll
                for (int e = 0; e < 4; ++e) { const int key = 4 * kg + e;
                    if (!samp) pre[e] = *(const u32x4*)(Vb + (size_t)(b * SEQ + 64 * j + key) * 1024 + 128 * hp + 8 * c16);
                    else if (j < 8) { const float* s = cache_v + ((size_t)(sb * 512 + 64 * j + key) * 1024 + 128 * hp + 8 * c16); const f32x4 x0 = *(const f32x4*)s, x1 = *(const f32x4*)(s + 4);
                        pre[e] = (u32x4){cvt_pk_bf16(x0[0], x0[1]), cvt_pk_bf16(x0[2], x0[3]), cvt_pk_bf16(x1[0], x1[1]), cvt_pk_bf16(x1[2], x1[3])}; }
                    else pre[e] = key < 16 ? *(const u32x4*)(Vb + (size_t)(T_P + 16 * sb + key) * 1024 + 128 * hp + 8 * c16) : (u32x4){0u, 0u, 0u, 0u}; }
            }
        };
        auto write_blk = [&](int buf) {
            if (tid < 256) {
                const int c16 = tid & 15;
#pragma unroll
                for (int e = 0; e < 4; ++e) { const int key = (tid >> 4) + 16 * e; *(LAS u32x4*)(L + buf * 36864 + (c16 >> 3) * 9216 + key * 144 + (c16 & 7) * 16) = pre[e]; }
            } else {
                const int u = tid - 256, kg = u >> 4, c16 = u & 15;
#pragma unroll
                for (int dd = 0; dd < 8; ++dd) { u32x2 w; w.x = pk16(pre[0], pre[1], dd); w.y = pk16(pre[2], pre[3], dd);
                    *(LAS u32x2*)(L + buf * 36864 + 18432 + (c16 >> 3) * 9216 + (8 * (c16 & 7) + dd) * 144 + ((((kg >> 3) * 4 + (kg & 3)) ^ (((c16 & 7) >> 1) | ((c16 >> 3) << 2))) * 16) + ((kg >> 2) & 1) * 8) = w; }
            }
        };
        load_blk(jlo); write_blk(0);
        __syncthreads();
        f32x4 O[4][4]; float m_run[4], lsum[4];
#pragma unroll
        for (int cc = 0; cc < 4; ++cc) { m_run[cc] = -1e30f; lsum[cc] = 0.f;
#pragma unroll
            for (int td = 0; td < 4; ++td) O[cc][td] = (f32x4){0.f, 0.f, 0.f, 0.f}; }
        const LAS float* tblh = tbl + hw * 640;
        const float c256 = tblh[639];
        int cur = 0;
        for (int j = jlo; j <= jhi; ++j) {
            if (j < jhi) load_blk(j + 1);
            if (wactive) {
                const LAS unsigned char* Kl = L + cur * 36864 + hw * 9216; const LAS unsigned char* Vl = L + cur * 36864 + 18432 + hw * 9216;
#pragma unroll
                for (int cc = 0; cc < 4; ++cc) {
                    const int jrel = samp ? j : j - (c0 + cc - 8);
                    if ((samp && cc > 0) || jrel < 0 || jrel > 8) continue;
                    f32x4 st[4];
                    if (jrel <= 3) {
#pragma unroll
                        for (int t = 0; t < 4; ++t) st[t] = (f32x4){c256, c256, c256, c256};
                    } else {
                        const int jb0 = 575 + 16 * qt + r - 64 * jrel - 4 * qq;
#pragma unroll
                        for (int t = 0; t < 4; ++t)
#pragma unroll
                            for (int i = 0; i < 4; ++i) st[t][i] = tblh[jb0 - 16 * t - i];
                    }
#pragma unroll
                    for (int t = 0; t < 4; ++t)
#pragma unroll
                        for (int ks = 0; ks < 2; ++ks) { const bf16x8 kf = *(const LAS bf16x8*)(Kl + (16 * t + r) * 144 + (32 * ks + 8 * qq) * 2); st[t] = mfma16(kf, qf[cc][ks], st[t]); }
                    if (samp && jrel == 8) {
#pragma unroll
                        for (int t = 1; t < 4; ++t) st[t] = (f32x4){-1e30f, -1e30f, -1e30f, -1e30f};
                    }
                    float mx = st[0][0];
#pragma unroll
                    for (int t = 0; t < 4; ++t)
#pragma unroll
                        for (int i = 0; i < 4; ++i) mx = fmaxf(mx, st[t][i]);
                    mx = fmaxf(mx, __shfl_xor(mx, 16)); mx = fmaxf(mx, __shfl_xor(mx, 32));
                    const float m_old = m_run[cc], m_new = mx > m_old + 8.f ? mx : m_old;
                    if (__any(m_new != m_old)) {
                        const float alpha = __builtin_amdgcn_exp2f(m_old - m_new); m_run[cc] = m_new; lsum[cc] *= alpha;
#pragma unroll
                        for (int td = 0; td < 4; ++td) O[cc][td] *= alpha;
                    }
                    float ps = 0.f;
#pragma unroll
                    for (int t = 0; t < 4; ++t)
#pragma unroll
                        for (int i = 0; i < 4; ++i) { st[t][i] = __builtin_amdgcn_exp2f(st[t][i] - m_new); ps += st[t][i]; }
                    lsum[cc] += ps;
                    bf16x8 pf[2];
#pragma unroll
                    for (int kk = 0; kk < 2; ++kk) { u32x4 w; w.x = cvt_pk_bf16(st[2 * kk][0], st[2 * kk][1]); w.y = cvt_pk_bf16(st[2 * kk][2], st[2 * kk][3]);
                        w.z = cvt_pk_bf16(st[2 * kk + 1][0], st[2 * kk + 1][1]); w.w = cvt_pk_bf16(st[2 * kk + 1][2], st[2 * kk + 1][3]); pf[kk] = __builtin_bit_cast(bf16x8, w); }
#pragma unroll
                    for (int td = 0; td < 4; ++td)
#pragma unroll
                        for (int kk = 0; kk < 2; ++kk) { const bf16x8 vf = *(const LAS bf16x8*)(Vl + (16 * td + r) * 144 + (((kk * 4 + qq) ^ (td | (hw << 2))) * 16));
                            O[cc][td] = mfma16(vf, pf[kk], O[cc][td]); }
                }
            }
            if (j < jhi) write_blk(cur ^ 1);
            __syncthreads();
            cur ^= 1;
        }
        if (wactive && (!DUMMY || lsum[0] == 12345.678f)) {
#pragma unroll
            for (int cc = 0; cc < 4; ++cc) {
                if (samp && cc > 0) continue;
                const int qrow = samp ? T_P + 16 * sb + r : b * SEQ + 64 * (c0 + cc) + 16 * qt + r;
                float ls = lsum[cc]; ls += __shfl_xor(ls, 16); ls += __shfl_xor(ls, 32);
                const float inv = 1.f / ls;
#pragma unroll
                for (int td = 0; td < 4; ++td) {
                    const size_t off = (size_t)qrow * 1024 + 64 * head + 16 * td + 4 * qq;
                    const u32x2 zw = *(const u32x2*)(ZA + off);
                    u32x2 w; w.x = cvt_pk_bf16(O[cc][td][0] * inv * bf_lo(zw.x), O[cc][td][1] * inv * bf_hi(zw.x)); w.y = cvt_pk_bf16(O[cc][td][2] * inv * bf_lo(zw.y), O[cc][td][3] * inv * bf_hi(zw.y));
                    *(u32x2*)(Qb + off) = w;
                }
            }
        }
    }
}

__device__ __forceinline__ void conv_phase() {
    const Args a = kargs();
    const int tid = tid_opaque();
    bf16_t* XBC = (bf16_t*)(a.ws + WS_XBC); const bf16_t* HALO = (const bf16_t*)(a.ws + WS_HALO); bf16_t* XBCS = (bf16_t*)(a.ws + WS_XBCS);
    const float* cw = a.in[16]; const float* cb = a.in[17]; const float* st_conv = a.in[6];
    for (int id = blockIdx.x; id < 512 * 6; id += gridDim.x) {
        const int cbk = id % 6, chunk = id / 6, oct = tid & 63, run = tid >> 6, col = 512 * cbk + 8 * oct, row0 = 64 * chunk + 8 * run;
        u32x4 u[11];
#pragma unroll
        for (int i = 0; i < 11; ++i) {
            if (i < 3 && run == 0) u[i] = (chunk & 127) == 0 ? (u32x4){0u, 0u, 0u, 0u} : *(const u32x4*)(HALO + ((size_t)(chunk - 1) * 3 + i) * CONVC + col);
            else u[i] = *(const u32x4*)(XBC + (size_t)(row0 - 3 + i) * CONVC + col);
        }
        asm volatile("s_waitcnt vmcnt(0)" ::: "memory");
        __syncthreads();
        float w[4][8], bb[8];
#pragma unroll
        for (int e = 0; e < 8; ++e) { bb[e] = cb[col + e];
#pragma unroll
            for (int j = 0; j < 4; ++j) w[j][e] = cw[j * CONVC + col + e]; }
#pragma unroll
        for (int t = 0; t < 8; ++t) {
            float o[8];
#pragma unroll
            for (int e = 0; e < 8; ++e) {
                float s = bb[e];
#pragma unroll
                for (int j = 0; j < 4; ++j) { const unsigned wd = (e >> 1) == 0 ? u[t + j].x : (e >> 1) == 1 ? u[t + j].y : (e >> 1) == 2 ? u[t + j].z : u[t + j].w; s += w[j][e] * ((e & 1) ? bf_hi(wd) : bf_lo(wd)); }
                o[e] = silu_f(s);
            }
            *(u32x4*)(XBC + (size_t)(row0 + t) * CONVC + col) = pack8(o);
        }
        __syncthreads();
    }
    for (int id = blockIdx.x * 512 + tid; id < T_S * 384; id += gridDim.x * 512) {
        const int oct = id % 384, rr = id / 384, sb = rr >> 4, t = rr & 15, col = 8 * oct;
        float o[8];
#pragma unroll
        for (int e = 0; e < 8; ++e) o[e] = cb[col + e];
#pragma unroll
        for (int j = 0; j < 4; ++j) {
            const int tt = t - 3 + j; float xv[8];
            if (tt >= 0) { const u32x4 q = *(const u32x4*)(XBC + (size_t)(T_P + 16 * sb + tt) * CONVC + col);
                xv[0] = bf_lo(q.x); xv[1] = bf_hi(q.x); xv[2] = bf_lo(q.y); xv[3] = bf_hi(q.y); xv[4] = bf_lo(q.z); xv[5] = bf_hi(q.z); xv[6] = bf_lo(q.w); xv[7] = bf_hi(q.w); }
            else { const float* s = st_conv + ((size_t)(sb * 3 + (tt + 3)) * CONVC + col);
#pragma unroll
                for (int e = 0; e < 8; ++e) xv[e] = s[e]; }
#pragma unroll
            for (int e = 0; e < 8; ++e) o[e] += cw[j * CONVC + col + e] * xv[e];
        }
#pragma unroll
        for (int e = 0; e < 8; ++e) o[e] = silu_f(o[e]);
        *(u32x4*)(XBCS + (size_t)rr * CONVC + col) = pack8(o);
    }
}

constexpr int SC_CS = 0, SC_BS = 17408, SC_BT = 34816, SC_XT = 53248, SC_LS = 62464, SC_HS = 71680, SC_XS = 89088, SC_ZS = 98304, SC_YS = 107520,
              SC_ACS = 116736, SC_WLS = 116992, SC_DTS = 117248, SC_SSL = 117504;
template <bool DUMMY> __device__ __forceinline__ void scan_phase(LAS unsigned char* L) {
    const Args a = kargs();
    const int tid = tid_opaque(), lane = tid & 63, wave = __builtin_amdgcn_readfirstlane(tid >> 6);
    const int r = lane & 15, qq = lane >> 4;
    const bf16_t* XBC = (const bf16_t*)(a.ws + WS_XBC); bf16_t* ZS = (bf16_t*)(a.ws + WS_ZS); const float* DT = (const float*)(a.ws + WS_DT);
    float* ssqp = (float*)(a.ws + WS_SSQP); float* ssqs = (float*)(a.ws + WS_SSQS);
    const float* a_log = a.in[19]; const float* d_skip = a.in[20];
    bf16_t* Y1 = (bf16_t*)(a.ws + WS_H); float* SST0 = (float*)(a.ws + WS_SST0); float* SST1 = (float*)(a.ws + WS_SST1); float* ACUM = (float*)(a.ws + WS_ACUM); float* ATOT = (float*)(a.ws + WS_ATOT);
    for (int id = blockIdx.x; id < NB * 32 * 2; id += gridDim.x) {
        const int combo = (id & 7) * 4 + (id >> 6), seg = combo & 1, g = (combo >> 1) & 3, b = combo >> 3, h = g * 8 + ((id >> 3) & 7), ck0 = 64 * seg;
        float arun = 0.f;
        const float a_h = -__expf(a_log[h]), dsk = d_skip[h];
        f32x4 Hacc[4];
#pragma unroll
        for (int t2 = 0; t2 < 4; ++t2) Hacc[t2] = (f32x4){0.f, 0.f, 0.f, 0.f};
        for (int i = tid; i < 17408 / 4; i += 512) *(LAS unsigned*)(L + SC_HS + 4 * i) = 0u;
        u32x4 pre[8]; float dtv = 0.f;
        const int xcol = 64 * h;
        auto load_ck = [&](int ck) {
            const size_t rowbase = (size_t)b * SEQ + 64 * ck;
            if (tid < 256) { const int u = tid & 127, rg = u >> 4, c = u & 15; const int col = (tid < 128 ? 2048 : 2560) + 128 * g + 8 * c;
#pragma unroll
                for (int e = 0; e < 8; ++e) pre[e] = *(const u32x4*)(XBC + (rowbase + 8 * rg + e) * CONVC + col);
            } else if (tid < 320) { const int u = tid - 256, rg = u >> 3, c = u & 7;
#pragma unroll
                for (int e = 0; e < 8; ++e) pre[e] = *(const u32x4*)(XBC + (rowbase + 8 * rg + e) * CONVC + xcol + 8 * c);
            } else if (tid < 384) { const int u = tid - 320, rg = u >> 3, c = u & 7;
#pragma unroll
                for (int e = 0; e < 8; ++e) pre[e] = *(const u32x4*)(ZS + (rowbase + 8 * rg + e) * SSDW + xcol + 8 * c);
            } else if (tid >= 448) dtv = DT[(rowbase + lane) * 32 + h];
        };
        int wck = ck0;
        auto write_ck = [&]() {
            if (tid < 256) { const int u = tid & 127, rg = u >> 4, c = u & 15; const int base = tid < 128 ? SC_BS : SC_CS;
#pragma unroll
                for (int e = 0; e < 8; ++e) *(LAS u32x4*)(L + base + (8 * rg + e) * 272 + c * 16) = pre[e];
                if (tid < 128) {
#pragma unroll
                    for (int dd = 0; dd < 8; ++dd) { u32x4 w; w.x = pk16(pre[0], pre[1], dd); w.y = pk16(pre[2], pre[3], dd); w.z = pk16(pre[4], pre[5], dd); w.w = pk16(pre[6], pre[7], dd);
                        *(LAS u32x4*)(L + SC_BT + (8 * c + dd) * 144 + ((rg ^ (c >> 1)) * 16)) = w; }
                }
            } else if (tid < 320) { const int u = tid - 256, rg = u >> 3, c = u & 7;
#pragma unroll
                for (int e = 0; e < 8; ++e) *(LAS u32x4*)(L + SC_XS + (8 * rg + e) * 144 + c * 16) = pre[e];
#pragma unroll
                for (int dd = 0; dd < 8; ++dd) { u32x4 w; w.x = pk16(pre[0], pre[1], dd); w.y = pk16(pre[2], pre[3], dd); w.z = pk16(pre[4], pre[5], dd); w.w = pk16(pre[6], pre[7], dd);
                    *(LAS u32x4*)(L + SC_XT + (8 * c + dd) * 144 + ((rg ^ (c >> 1)) * 16)) = w; }
            } else if (tid < 384) { const int u = tid - 320, rg = u >> 3, c = u & 7;
#pragma unroll
                for (int e = 0; e < 8; ++e) *(LAS u32x4*)(L + SC_ZS + (8 * rg + e) * 144 + c * 16) = pre[e];
            } else if (tid >= 448) {
                float x = dtv * a_h;
#pragma unroll
                for (int o = 1; o < 64; o <<= 1) { const float y = __shfl_up(x, o); if (lane >= o) x += y; }
                const float tot = __shfl(x, 63);
                if (seg == 1) ACUM[(size_t)(b * 32 + h) * 4096 + 64 * (wck - 64) + lane] = arun + x;
                arun += tot;
                ((LAS float*)(L + SC_ACS))[lane] = x; ((LAS float*)(L + SC_WLS))[lane] = dtv * __expf(tot - x); ((LAS float*)(L + SC_DTS))[lane] = dtv;
            }
        };
        load_ck(ck0);
        const int tl = wave >> 1, tpb = 2 * (wave & 1);
        for (int ck = ck0; ck < ck0 + 64; ++ck) {
            const size_t rowbase = (size_t)b * SEQ + 64 * ck;
            wck = ck;
            write_ck();
            if (ck + 1 < ck0 + 64) load_ck(ck + 1);
            __syncthreads();
            {
#pragma unroll
                for (int tsi = 0; tsi < 2; ++tsi) {
                    const int ts = tpb + tsi; const int l = 16 * tl + r;
                    u32x2 w = (u32x2){0u, 0u};
                    if (ts <= tl) {
                        f32x4 cbv = (f32x4){0.f, 0.f, 0.f, 0.f};
#pragma unroll
                        for (int ks = 0; ks < 4; ++ks) { const bf16x8 af = *(const LAS bf16x8*)(L + SC_BS + (16 * ts + r) * 272 + (32 * ks + 8 * qq) * 2);
                            const bf16x8 bf = *(const LAS bf16x8*)(L + SC_CS + (16 * tl + r) * 272 + (32 * ks + 8 * qq) * 2); cbv = mfma16(af, bf, cbv); }
                        const float al = ((const LAS float*)(L + SC_ACS))[l];
                        const f32x4 as4 = *(const LAS f32x4*)(L + SC_ACS + (16 * ts + 4 * qq) * 4), dt4 = *(const LAS f32x4*)(L + SC_DTS + (16 * ts + 4 * qq) * 4);
                        float v[4];
#pragma unroll
                        for (int i = 0; i < 4; ++i) { const int s = 16 * ts + 4 * qq + i; const float d = fminf(al - as4[i], 0.f); v[i] = s <= l ? cbv[i] * __expf(d) * dt4[i] : 0.f; }
                        w.x = cvt_pk_bf16(v[0], v[1]); w.y = cvt_pk_bf16(v[2], v[3]);
                    }
                    *(LAS u32x2*)(L + SC_LS + l * 144 + (16 * ts + 4 * qq) * 2) = w;
                }
            }
            f32x4 yst[2]; yst[0] = (f32x4){0.f, 0.f, 0.f, 0.f}; yst[1] = (f32x4){0.f, 0.f, 0.f, 0.f};
#pragma unroll
            for (int ks = 0; ks < 4; ++ks) { const bf16x8 bf = *(const LAS bf16x8*)(L + SC_CS + (16 * tl + r) * 272 + (32 * ks + 8 * qq) * 2);
#pragma unroll
                for (int tpi = 0; tpi < 2; ++tpi) { const bf16x8 af = *(const LAS bf16x8*)(L + SC_HS + (16 * (tpb + tpi) + r) * 272 + (32 * ks + 8 * qq) * 2); yst[tpi] = mfma16(af, bf, yst[tpi]); } }
            __syncthreads();
            {
                f32x4 yin[2]; yin[0] = (f32x4){0.f, 0.f, 0.f, 0.f}; yin[1] = (f32x4){0.f, 0.f, 0.f, 0.f};
#pragma unroll
                for (int ks = 0; ks < 2; ++ks) { const bf16x8 bf = *(const LAS bf16x8*)(L + SC_LS + (16 * tl + r) * 144 + (32 * ks + 8 * qq) * 2);
#pragma unroll
                    for (int tpi = 0; tpi < 2; ++tpi) { const bf16x8 af = *(const LAS bf16x8*)(L + SC_XT + (16 * (tpb + tpi) + r) * 144 + (((4 * ks + qq) ^ (tpb + tpi)) * 16)); yin[tpi] = mfma16(af, bf, yin[tpi]); } }
                const int l = 16 * tl + r;
                const float el = __expf(((const LAS float*)(L + SC_ACS))[l]);
                float ss = 0.f;
#pragma unroll
                for (int tpi = 0; tpi < 2; ++tpi) {
                    const int po = (16 * (tpb + tpi) + 4 * qq) * 2;
                    const u32x2 xw = *(const LAS u32x2*)(L + SC_XS + l * 144 + po), zw = *(const LAS u32x2*)(L + SC_ZS + l * 144 + po);
                    const float xv[4] = {bf_lo(xw.x), bf_hi(xw.x), bf_lo(xw.y), bf_hi(xw.y)}, zv[4] = {bf_lo(zw.x), bf_hi(zw.x), bf_lo(zw.y), bf_hi(zw.y)};
                    float gy[4];
#pragma unroll
                    for (int i = 0; i < 4; ++i) { gy[i] = (yin[tpi][i] + el * yst[tpi][i] + dsk * xv[i]) * zv[i]; ss += gy[i] * gy[i]; }
                    *(LAS u32x2*)(L + SC_YS + l * 144 + po) = (u32x2){cvt_pk_bf16(gy[0], gy[1]), cvt_pk_bf16(gy[2], gy[3])};
                }
                ss += __shfl_xor(ss, 16); ss += __shfl_xor(ss, 32);
                if (qq == 0) ((LAS float*)(L + SC_SSL))[(wave & 1) * 64 + l] = ss;
                const float E = __expf(((const LAS float*)(L + SC_ACS))[63]);
                const int t2 = wave & 3, nb = 4 * (wave >> 2);
                bf16x8 xsc[2];
#pragma unroll
                for (int ks = 0; ks < 2; ++ks) {
                    const u32x4 raw = *(const LAS u32x4*)(L + SC_XT + (16 * t2 + r) * 144 + (((4 * ks + qq) ^ t2) * 16));
                    const f32x4 w0 = *(const LAS f32x4*)(L + SC_WLS + (32 * ks + 8 * qq) * 4), w1 = *(const LAS f32x4*)(L + SC_WLS + (32 * ks + 8 * qq + 4) * 4);
                    u32x4 sc; sc.x = cvt_pk_bf16(bf_lo(raw.x) * w0[0], bf_hi(raw.x) * w0[1]); sc.y = cvt_pk_bf16(bf_lo(raw.y) * w0[2], bf_hi(raw.y) * w0[3]);
                    sc.z = cvt_pk_bf16(bf_lo(raw.z) * w1[0], bf_hi(raw.z) * w1[1]); sc.w = cvt_pk_bf16(bf_lo(raw.w) * w1[2], bf_hi(raw.w) * w1[3]);
                    xsc[ks] = __builtin_bit_cast(bf16x8, sc);
                }
#pragma unroll
                for (int j = 0; j < 4; ++j) {
                    Hacc[j] *= E;
#pragma unroll
                    for (int ks = 0; ks < 2; ++ks) { const bf16x8 bfr = *(const LAS bf16x8*)(L + SC_BT + (16 * (nb + j) + r) * 144 + (((4 * ks + qq) ^ ((nb + j) & 7)) * 16)); Hacc[j] = mfma16(bfr, xsc[ks], Hacc[j]); }
                    *(LAS u32x2*)(L + SC_HS + (16 * t2 + r) * 272 + (16 * (nb + j) + 4 * qq) * 2) = (u32x2){cvt_pk_bf16(Hacc[j][0], Hacc[j][1]), cvt_pk_bf16(Hacc[j][2], Hacc[j][3])};
                }
            }
            __syncthreads();
            if (!DUMMY) { const int row = tid >> 3, c = tid & 7; const u32x4 v = *(const LAS u32x4*)(L + SC_YS + row * 144 + c * 16);
              if (seg == 0) *(u32x4*)(ZS + (rowbase + row) * SSDW + xcol + 8 * c) = v;
              else *(u32x4*)(Y1 + ((size_t)b * 4096 + 64 * (ck - 64) + row) * SSDW + xcol + 8 * c) = v; }
            if (!DUMMY && seg == 0 && tid < 64) { const float v = ((const LAS float*)(L + SC_SSL))[tid] + ((const LAS float*)(L + SC_SSL))[64 + tid];
                ssqp[(size_t)(g * 8 + (h & 7)) * T_P + rowbase + tid] = v; }
        }
#pragma unroll
        for (int j = 0; j < 4; ++j) *(f32x4*)((seg == 0 ? SST0 : SST1) + ((size_t)((b * 32 + h) * 64 + 16 * (wave & 3) + r)) * 128 + 16 * (4 * (wave >> 2) + j) + 4 * qq) = Hacc[j];
        if (seg == 1 && tid == 448) ATOT[b * 32 + h] = arun;
        __syncthreads();
    }
    {
        const bf16_t* XBCS = (const bf16_t*)(a.ws + WS_XBCS); const float* st_ssm = a.in[7];
        LAS float* xs = (LAS float*)L;
        LAS float* Bv = xs + 1024;
        LAS float* Cv = Bv + 2048;
        LAS float* acs = Cv + 2048;
        LAS float* dtl = acs + 16;
        LAS float* Lm = dtl + 16;
        LAS float* wl16 = Lm + 256;
        LAS float* hst = wl16 + 16;
        const int G = gridDim.x;
        const int s0 = (int)blockIdx.x, sstep = G;
        for (int id = DUMMY ? NSB * 32 : s0; id < NSB * 32; id += sstep) {
            const int h = id & 31, sb = id >> 5, g = h >> 3;
            const float a_h = -__expf(a_log[h]), dsk = d_skip[h];
            __syncthreads();
            _Pragma("clang loop unroll(disable) vectorize(disable)") for (int i = tid; i < 1024; i += 512) { const int t = i >> 6, p = i & 63; xs[i] = __uint_as_float((unsigned)XBCS[(size_t)(16 * sb + t) * CONVC + 64 * h + p] << 16); }
            _Pragma("clang loop unroll(disable) vectorize(disable)") for (int i = tid; i < 2048; i += 512) { const int t = i >> 7, n = i & 127; Bv[i] = __uint_as_float((unsigned)XBCS[(size_t)(16 * sb + t) * CONVC + 2048 + 128 * g + n] << 16);
                Cv[i] = __uint_as_float((unsigned)XBCS[(size_t)(16 * sb + t) * CONVC + 2560 + 128 * g + n] << 16); }
            _Pragma("clang loop unroll(disable) vectorize(disable)") for (int i = tid; i < 8192; i += 512) { const int p = i >> 7, n = i & 127; hst[p * 129 + n] = st_ssm[((size_t)(sb * 32 + h) * 64 + p) * 128 + n]; }
            if (tid == 0) { float c = 0.f; for (int t = 0; t < 16; ++t) { const float d = DT[(size_t)(T_P + 16 * sb + t) * 32 + h]; c += d * a_h; acs[t] = c; dtl[t] = d; }
                for (int t = 0; t < 16; ++t) wl16[t] = dtl[t] * __expf(c - acs[t]); }
            __syncthreads();
            if (tid < 256) { const int l = tid >> 4, s = tid & 15; float v = 0.f;
                if (s <= l) { float dsum = 0.f; _Pragma("clang loop unroll_count(4)") for (int n = 0; n < 128; ++n) dsum += Cv[l * 128 + n] * Bv[s * 128 + n]; v = dsum * __expf(acs[l] - acs[s]) * dtl[s]; }
                Lm[tid] = v; }
            __syncthreads();
            _Pragma("clang loop unroll(disable) vectorize(disable)") for (int j = 0; j < 2; ++j) {
                const int i = tid + 512 * j, l = i >> 6, p = i & 63;
                float y = 0.f;
                _Pragma("clang loop unroll(disable) vectorize(disable)") for (int s = 0; s <= l; ++s) y += Lm[l * 16 + s] * xs[s * 64 + p];
                float ys = 0.f;
                _Pragma("clang loop unroll_count(4)") for (int n = 0; n < 128; ++n) ys += Cv[l * 128 + n] * hst[p * 129 + n];
                y += __expf(acs[l]) * ys + dsk * xs[l * 64 + p];
                const size_t off = (size_t)(T_P + 16 * sb + l) * SSDW + 64 * h + p;
                const float gy = y * __uint_as_float((unsigned)ZS[off] << 16);
                float ss = gy * gy;
#pragma unroll
                for (int o = 1; o < 64; o <<= 1) ss += __shfl_xor(ss, o);
                if (lane == 0) ssqs[(size_t)(sb * 32 + h) * 32 + l] = ss;
                ZS[off] = (bf16_t)(cvt_pk_bf16(gy, 0.f) & 0xffffu);
            }
            const float E = __expf(acs[15]);
            _Pragma("clang loop unroll(disable) vectorize(disable)") for (int j = 0; j < 16; ++j) {
                const int i = tid + 512 * j, p = i >> 7, n = i & 127;
                float v = hst[p * 129 + n] * E;
                _Pragma("clang loop unroll(disable) vectorize(disable)") for (int l = 0; l < 16; ++l) v += Bv[l * 128 + n] * xs[l * 64 + p] * wl16[l];
                a.out[O_HS + ((size_t)(sb * 32 + h) * 64 + p) * 128 + n] = v;
            }
        }
        __syncthreads();
    }
}

template <bool DUMMY> __device__ __forceinline__ void scanfix_phase(LAS unsigned char* L) {
    const Args a = kargs();
    const int tid = tid_opaque(), lane = tid & 63, wave = __builtin_amdgcn_readfirstlane(tid >> 6);
    const int r = lane & 15, qq = lane >> 4;
    const bf16_t* XBC = (const bf16_t*)(a.ws + WS_XBC); bf16_t* ZS = (bf16_t*)(a.ws + WS_ZS); const bf16_t* Y1 = (const bf16_t*)(a.ws + WS_H);
    const float* SST0 = (const float*)(a.ws + WS_SST0); const float* SST1 = (const float*)(a.ws + WS_SST1); const float* ACUM = (const float*)(a.ws + WS_ACUM); const float* ATOT = (const float*)(a.ws + WS_ATOT);
    float* ssqp = (float*)(a.ws + WS_SSQP);
    constexpr int FX_HS = 0, FX_CS = 17408, FX_SSL = 34816;
    for (int id = blockIdx.x; id < NB * 32 * 2; id += gridDim.x) {
        const int combo = (id & 7) * 4 + (id >> 6), half = combo & 1, g = (combo >> 1) & 3, b = combo >> 3, h = g * 8 + ((id >> 3) & 7), bh = b * 32 + h;
        __syncthreads();
        const float eA = __expf(ATOT[bh]);
#pragma unroll
        for (int j = 0; j < 4; ++j) {
            const int e4 = tid + 512 * j, p = e4 >> 5, n = (e4 & 31) * 4;
            const f32x4 s0 = *(const f32x4*)(SST0 + ((size_t)bh * 64 + p) * 128 + n);
            *(LAS u32x2*)(L + FX_HS + p * 272 + n * 2) = (u32x2){cvt_pk_bf16(s0[0], s0[1]), cvt_pk_bf16(s0[2], s0[3])};
            if (!DUMMY && half == 0) { const f32x4 s1 = *(const f32x4*)(SST1 + ((size_t)bh * 64 + p) * 128 + n); *(f32x4*)(a.out + O_HP + ((size_t)bh * 64 + p) * 128 + n) = s1 + s0 * eA; }
        }
        const int tl = wave >> 1, tpb = 2 * (wave & 1);
        u32x4 cpre[2];
        { const size_t rb0 = (size_t)b * SEQ + 64 * (64 + 32 * half);
#pragma unroll
          for (int j = 0; j < 2; ++j) { const int e = tid + 512 * j, row = e >> 4, c = e & 15; cpre[j] = *(const u32x4*)(XBC + (rb0 + row) * CONVC + 2560 + 128 * g + 8 * c); } }
        for (int cki = 0; cki < 32; ++cki) {
            const int ck = 64 + 32 * half + cki;
            const size_t rowbase = (size_t)b * SEQ + 64 * ck, y1base = (size_t)b * 4096 + 64 * (ck - 64);
#pragma unroll
            for (int j = 0; j < 2; ++j) { const int e = tid + 512 * j, row = e >> 4, c = e & 15; *(LAS u32x4*)(L + FX_CS + row * 272 + c * 16) = cpre[j]; }
            __syncthreads();
            if (cki + 1 < 32) {
#pragma unroll
                for (int j = 0; j < 2; ++j) { const int e = tid + 512 * j, row = e >> 4, c = e & 15; cpre[j] = *(const u32x4*)(XBC + (rowbase + 64 + row) * CONVC + 2560 + 128 * g + 8 * c); }
            }
            const int l = 16 * tl + r;
            const float acv = ACUM[(size_t)bh * 4096 + 64 * (ck - 64) + l];
            u32x2 yw[2], zw[2];
#pragma unroll
            for (int tpi = 0; tpi < 2; ++tpi) { const int col = 64 * h + 16 * (tpb + tpi) + 4 * qq;
                yw[tpi] = *(const u32x2*)(Y1 + (y1base + l) * SSDW + col); zw[tpi] = *(const u32x2*)(ZS + (rowbase + l) * SSDW + col); }
            f32x4 yf[2]; yf[0] = (f32x4){0.f, 0.f, 0.f, 0.f}; yf[1] = (f32x4){0.f, 0.f, 0.f, 0.f};
#pragma unroll
            for (int ks = 0; ks < 4; ++ks) { const bf16x8 bf = *(const LAS bf16x8*)(L + FX_CS + (16 * tl + r) * 272 + (32 * ks + 8 * qq) * 2);
#pragma unroll
                for (int tpi = 0; tpi < 2; ++tpi) { const bf16x8 af = *(const LAS bf16x8*)(L + FX_HS + (16 * (tpb + tpi) + r) * 272 + (32 * ks + 8 * qq) * 2); yf[tpi] = mfma16(af, bf, yf[tpi]); } }
            const float el = __expf(acv);
            float ss = 0.f;
#pragma unroll
            for (int tpi = 0; tpi < 2; ++tpi) {
                const int col = 64 * h + 16 * (tpb + tpi) + 4 * qq;
                float gy[4];
                gy[0] = bf_lo(yw[tpi].x) + el * yf[tpi][0] * bf_lo(zw[tpi].x); gy[1] = bf_hi(yw[tpi].x) + el * yf[tpi][1] * bf_hi(zw[tpi].x);
                gy[2] = bf_lo(yw[tpi].y) + el * yf[tpi][2] * bf_lo(zw[tpi].y); gy[3] = bf_hi(yw[tpi].y) + el * yf[tpi][3] * bf_hi(zw[tpi].y);
#pragma unroll
                for (int i = 0; i < 4; ++i) ss += gy[i] * gy[i];
                if (!DUMMY || ss == 12345.678f) *(u32x2*)(ZS + (rowbase + l) * SSDW + col) = (u32x2){cvt_pk_bf16(gy[0], gy[1]), cvt_pk_bf16(gy[2], gy[3])};
            }
            ss += __shfl_xor(ss, 16); ss += __shfl_xor(ss, 32);
            if (qq == 0) ((LAS float*)(L + FX_SSL))[(wave & 1) * 64 + l] = ss;
            __syncthreads();
            if (!DUMMY && tid < 64) ssqp[(size_t)h * T_P + rowbase + tid] = ((const LAS float*)(L + FX_SSL))[tid] + ((const LAS float*)(L + FX_SSL))[64 + tid];
        }
    }
}

__device__ __forceinline__ void ynorm_phase() {
    const Args a = kargs();
    const int tid = tid_opaque(), lane = tid & 63, wave = tid >> 6;
    bf16_t* Y = (bf16_t*)(a.ws + WS_ZS); const float* ssqp = (const float*)(a.ws + WS_SSQP); const float* ssqs = (const float*)(a.ws + WS_SSQS);
    const int gw = blockIdx.x * 8 + wave, NGW = gridDim.x * 8;
    for (int row = gw; row < T_ALL; row += NGW) {
        float sv = 0.f;
        if (lane < 32) sv = row < T_P ? ssqp[(size_t)lane * T_P + row] : ssqs[(size_t)(((row - T_P) >> 4) * 32 + lane) * 32 + ((row - T_P) & 15)];
        sv += __shfl_xor(sv, 1); sv += __shfl_xor(sv, 2); sv += __shfl_xor(sv, 4);
        const float s4[4] = {__shfl(sv, 0), __shfl(sv, 8), __shfl(sv, 16), __shfl(sv, 24)};
        u32x4* p = (u32x4*)(Y + (size_t)row * SSDW) + lane;
#pragma unroll
        for (int j = 0; j < 4; ++j) {
            const float rinv = rsqrtf(s4[j] * (1.f / 512.f) + EPS);
            const u32x4 v = p[64 * j];
            u32x4 o; o.x = cvt_pk_bf16(bf_lo(v.x) * rinv, bf_hi(v.x) * rinv); o.y = cvt_pk_bf16(bf_lo(v.y) * rinv, bf_hi(v.y) * rinv);
            o.z = cvt_pk_bf16(bf_lo(v.z) * rinv, bf_hi(v.z) * rinv); o.w = cvt_pk_bf16(bf_lo(v.w) * rinv, bf_hi(v.w) * rinv);
            p[64 * j] = o;
        }
    }
}

template <int MODE>
__device__ __forceinline__ void mini_gemm(const bf16_t* A, const bf16_t* Bt, int K, bf16_t* Mo, const unsigned char* gates, float* out, const float* xs, const float* mod) {
    const int tid = tid_opaque(), lane = tid & 63, wave = __builtin_amdgcn_readfirstlane(tid >> 6), r = lane & 15, qq = lane >> 4;
    for (int t = blockIdx.x; t < 64; t += gridDim.x) {
        const int n0 = 16 * t, jj = n0 & 255;
        const int prow = (n0 & ~255) + 128 * ((jj >> 5) & 1) + 32 * (jj >> 6) + (jj & 31);
        const bf16_t* ap = A + (size_t)(T_P + 16 * wave + r) * K + 8 * qq;
        const bf16_t* bp = Bt + (size_t)(prow + r) * K + 8 * qq;
        f32x4 acc = (f32x4){0.f, 0.f, 0.f, 0.f};
#pragma unroll 8
        for (int k = 0; k < K; k += 32) { const bf16x8 af = *(const bf16x8*)(ap + k), bf = *(const bf16x8*)(bp + k); acc = mfma16(bf, af, acc); }
        const int row = T_P + 16 * wave + r, col = n0 + 4 * qq;
        if (MODE == 0) {
            const u32x2 gw = *(const u32x2*)(gates + (size_t)row * 4096 + (size_t)col * 2);
            *(u32x2*)(Mo + (size_t)row * 1024 + col) = (u32x2){cvt_pk_bf16(bf_lo(gw.x) * acc[0], bf_hi(gw.x) * acc[1]), cvt_pk_bf16(bf_lo(gw.y) * acc[2], bf_hi(gw.y) * acc[3])};
        } else if (MODE == 1) {
            const u32x2 gw = *(const u32x2*)(gates + (size_t)row * 4096 + (size_t)(1024 + col) * 2); const u32x2 mw = *(const u32x2*)(Mo + (size_t)row * 1024 + col);
            *(u32x2*)(Mo + (size_t)row * 1024 + col) = (u32x2){cvt_pk_bf16(bf_lo(mw.x) + bf_lo(gw.x) * acc[0], bf_hi(mw.x) + bf_hi(gw.x) * acc[1]), cvt_pk_bf16(bf_lo(mw.y) + bf_lo(gw.y) * acc[2], bf_hi(mw.y) + bf_hi(gw.y) * acc[3])};
        } else {
            const int r12 = 4 + ((row - T_P) >> 4);
            const f32x4 xv = *(const f32x4*)(xs + (size_t)(row - T_P) * 1024 + col), gv = *(const f32x4*)(mod + (size_t)r12 * 3072 + 2048 + col);
            *(f32x4*)(out + (size_t)row * 1024 + col) = xv + gv * acc;
        }
    }
}

#define XB_TMO      128
#define XB_XCNT(j)  (256  + 64 * (j))
#define XB_XSUB(j)  (1280 + 64 * (j))
#define XB_XGEN(j)  (2304 + 64 * (j))
#define XB_TOP      3328
#define XB_TOPGEN   3392
#define XCD_BAR_WORDS 3456
#define XB_SPIN_CAP (1u << 18)

__device__ __forceinline__ unsigned xb_ld(unsigned* p)              { return __hip_atomic_load(p, __ATOMIC_RELAXED, __HIP_MEMORY_SCOPE_AGENT); }
__device__ __forceinline__ unsigned xb_add(unsigned* p, unsigned v) { return __hip_atomic_fetch_add(p, v, __ATOMIC_RELAXED, __HIP_MEMORY_SCOPE_AGENT); }
__device__ __forceinline__ unsigned xb_xcc_id() { return (unsigned)__builtin_amdgcn_s_getreg((3 << 11) | 20) & 0xFu; }
#define XB_SPIN(cond, bar) do { unsigned _sp = 0; while (cond) { __builtin_amdgcn_s_sleep(1); \
    if ((++_sp & 255u) == 0u) { if (xb_ld(&(bar)[XB_TMO])) break; if (_sp > XB_SPIN_CAP) { atomicAdd(&(bar)[XB_TMO], 1u); break; } } } } while (0)

struct XcdBarrier {
    unsigned* bar; unsigned x;
    volatile LAS unsigned* st;
};

__device__ __forceinline__ XcdBarrier xcd_barrier_post(unsigned* bar, volatile LAS unsigned* st) {
    XcdBarrier b; b.bar = bar; b.x = xb_xcc_id(); b.st = st;
    if (threadIdx.x == 0) (void)xb_add(&bar[XB_XCNT(b.x)], 1u);
    return b;
}
__device__ __forceinline__ void xcd_barrier_complete(unsigned* bar, unsigned x, unsigned& nloc, unsigned& nx) {
    const unsigned G = gridDim.x * gridDim.y * gridDim.z;
    unsigned sum, cnt, mine, sp = 0u;
    for (;;) {
        sum = 0u; cnt = 0u; mine = 0u;
#pragma unroll
        for (unsigned j = 0; j < 16; ++j) { const unsigned c = xb_ld(&bar[XB_XCNT(j)]); sum += c; cnt += (c > 0u) ? 1u : 0u; mine = (j == x) ? c : mine; }
        if (sum == G) break;
        __builtin_amdgcn_s_sleep(1);
        if ((++sp & 255u) == 0u) { if (xb_ld(&bar[XB_TMO])) break; if (sp > XB_SPIN_CAP) { atomicAdd(&bar[XB_TMO], 1u); break; } }
    }
    nloc = mine > 0u ? mine : 1u; nx = cnt > 0u ? cnt : 1u;
}

__device__ __forceinline__ void xcd_barrier(const XcdBarrier& b) {
    asm volatile("s_waitcnt vmcnt(0)" ::: "memory");
    __syncthreads();
    if (threadIdx.x == 0) {
        unsigned* bar = b.bar;
        __builtin_amdgcn_s_waitcnt(0);
        unsigned nloc = b.st[0], nx = b.st[1];
        if (nloc == 0u) { xcd_barrier_complete(bar, b.x, nloc, nx); b.st[0] = nloc; b.st[1] = nx; }
        const unsigned old = xb_add(&bar[XB_XSUB(b.x)], 1u);
        const unsigned gen = old / nloc;
        if (old + 1u == (gen + 1u) * nloc) {
            __builtin_amdgcn_fence(__ATOMIC_RELEASE, "agent");
            asm volatile("s_waitcnt vmcnt(0)" ::: "memory");
            const unsigned og = xb_add(&bar[XB_TOP], 1u);
            const unsigned tg = og / nx;
            if (og + 1u == (tg + 1u) * nx) xb_add(&bar[XB_TOPGEN], 1u);
            else XB_SPIN(xb_ld(&bar[XB_TOPGEN]) == tg, bar);
            __builtin_amdgcn_fence(__ATOMIC_ACQUIRE, "agent");
            xb_add(&bar[XB_XGEN(b.x)], 1u);
            asm volatile("s_waitcnt vmcnt(0)" ::: "memory");
        } else {
            XB_SPIN(xb_ld(&bar[XB_XGEN(b.x)]) == gen, bar);
            __builtin_amdgcn_fence(__ATOMIC_ACQUIRE, "agent");
            asm volatile("s_waitcnt vmcnt(0)" ::: "memory");
        }
    }
    __syncthreads();
}


constexpr size_t WS_BAR = 200 * 1024;
__device__ __forceinline__ void grid_barrier(unsigned* bar, unsigned& gen) {
    asm volatile("s_waitcnt vmcnt(0) lgkmcnt(0)" ::: "memory");
    __syncthreads();
    ++gen;
    if (threadIdx.x == 0) {
        __builtin_amdgcn_fence(__ATOMIC_RELEASE, "agent");
        asm volatile("s_waitcnt vmcnt(0)" ::: "memory");
        const unsigned target = gen * gridDim.x;
        __hip_atomic_fetch_add(bar, 1u, __ATOMIC_RELAXED, __HIP_MEMORY_SCOPE_AGENT);
        while (__hip_atomic_load(bar, __ATOMIC_RELAXED, __HIP_MEMORY_SCOPE_AGENT) < target) __builtin_amdgcn_s_sleep(1);
        __builtin_amdgcn_fence(__ATOMIC_ACQUIRE, "agent");
        asm volatile("s_waitcnt vmcnt(0)" ::: "memory");
    }
    __syncthreads();
}

__global__ void __launch_bounds__(512, 2) fwd_megakernel(Args a_in) {
    extern __shared__ __attribute__((aligned(16))) unsigned char lds_raw[];
    LAS unsigned char* L = (LAS unsigned char*)lds_raw;
    cg::grid_group grid = cg::this_grid();
    const int G = gridDim.x, c = blockIdx.x;
    if (gridDim.y == 0x7fffu) grid.sync();
    unsigned* bar; { const Args a = kargs(); bar = (unsigned*)(a.ws + WS_BAR); }
    unsigned gen = 0; (void)gen;
    volatile LAS unsigned* xst = (volatile LAS unsigned*)(L + LDS_BYTES - 64);
    if (threadIdx.x == 0) { xst[0] = 0u; xst[1] = 0u; }
    __syncthreads();
    const XcdBarrier xbar = xcd_barrier_post(bar, xst);
#define GRID_SYNC() xcd_barrier(xbar)

    phase0(L);
#if defined(DUP_P01)
    GRID_SYNC();
    phase1();
    GRID_SYNC();
    phase0(L);
#endif
    GRID_SYNC();
#if defined(STOP_AFTER)
    if (STOP_AFTER == 1) return;
#endif
    phase1();
    GRID_SYNC();
#if defined(STOP_AFTER)
    if (STOP_AFTER == 2) return;
#endif
    {
        const Args a = kargs(); unsigned char* ws = a.ws;
        pg8::Gemm g{(const bf16_t*)(ws + WS_H), (const bf16_t*)(ws + WS_WIN), M_PAD, NT1 * 256, 1024}; pg8::StaticOrder S; S.init(M_PAD, NT1 * 256, G, c);
        EpiIn1 E{(bf16_t*)(ws + WS_Q), (bf16_t*)(ws + WS_K), (bf16_t*)(ws + WS_V), (bf16_t*)(ws + WS_ZA), (unsigned char*)a.out, a.out, a.in[12], a.in[13]};
        pg8::gemm_phase<EpiIn1, pg8::StaticOrder, true, true>(L, g, S, E);
#if defined(DUP_P2)
        __syncthreads();
        pg8::gemm_phase<EpiIn1, pg8::StaticOrder, true, true>(L, g, S, E);
#endif
    }
    GRID_SYNC();
#if defined(STOP_AFTER)
    if (STOP_AFTER == 3) return;
#endif
#if defined(DUP_ATTN)
    attn_phase<true>(L);
#endif
    attn_phase<false>(L);
    GRID_SYNC();
#if defined(STOP_AFTER)
    if (STOP_AFTER == 4) return;
#endif
    {
        const Args a = kargs(); unsigned char* ws = a.ws;
        pg8::Gemm g{(const bf16_t*)(ws + WS_H), (const bf16_t*)(ws + WS_WIN) + (size_t)NT1 * 256 * 1024, M_PAD, NT2 * 256, 1024}; pg8::StaticOrder S; S.init(M_PAD, NT2 * 256, G, c);
        EpiIn2 E{(bf16_t*)(ws + WS_ZS), (bf16_t*)(ws + WS_XBC), (bf16_t*)(ws + WS_HALO), (float*)(ws + WS_DT), a.out, a.in[18]};
        pg8::gemm_phase<EpiIn2, pg8::StaticOrder, true, true>(L, g, S, E);
#if defined(DUP_P4)
        __syncthreads();
        pg8::gemm_phase<EpiIn2, pg8::StaticOrder, true, true>(L, g, S, E);
#endif
    }
    GRID_SYNC();
#if defined(STOP_AFTER)
    if (STOP_AFTER == 5) return;
#endif
    conv_phase();
    GRID_SYNC();
#if defined(STOP_AFTER)
    if (STOP_AFTER == 6) return;
#endif
#if defined(DUP_SCAN)
    scan_phase<true>(L);
#endif
    scan_phase<false>(L);
    GRID_SYNC();
#if defined(DUP_FIX)
    scanfix_phase<true>(L);
#endif
    scanfix_phase<false>(L);
    GRID_SYNC();
#if defined(STOP_AFTER)
    if (STOP_AFTER == 7) return;
#endif
    ynorm_phase();
    {
        const Args a = kargs(); unsigned char* ws = a.ws;
        pg8::Gemm g{(const bf16_t*)(ws + WS_Q), (const bf16_t*)(ws + WS_WATT), T_P, 1024, 1024}; pg8::StaticOrder S; S.init(T_P, 1024, G, c);
        EpiA E{(bf16_t*)(ws + WS_H), (const unsigned char*)a.out};
        pg8::gemm_phase<EpiA, pg8::StaticOrder, true, true>(L, g, S, E);
        mini_gemm<0>((const bf16_t*)(ws + WS_Q), (const bf16_t*)(ws + WS_WATT), 1024, (bf16_t*)(ws + WS_H), (const unsigned char*)a.out, nullptr, nullptr, nullptr);
    }
    GRID_SYNC();
#if defined(STOP_AFTER)
    if (STOP_AFTER == 8) return;
#endif
    {
        const Args a = kargs(); unsigned char* ws = a.ws;
        pg8::Gemm g{(const bf16_t*)(ws + WS_ZS), (const bf16_t*)(ws + WS_WSSD), T_P, 1024, 2048}; pg8::StaticOrder S; S.init(T_P, 1024, G, c);
        EpiB E{(bf16_t*)(ws + WS_H), (const unsigned char*)a.out};
        pg8::gemm_phase<EpiB, pg8::StaticOrder, true, true>(L, g, S, E);
        mini_gemm<1>((const bf16_t*)(ws + WS_ZS), (const bf16_t*)(ws + WS_WSSD), 2048, (bf16_t*)(ws + WS_H), (const unsigned char*)a.out, nullptr, nullptr, nullptr);
    }
    GRID_SYNC();
#if defined(STOP_AFTER)
    if (STOP_AFTER == 9) return;
#endif
    {
        const Args a = kargs(); unsigned char* ws = a.ws;
        pg8::Gemm g{(const bf16_t*)(ws + WS_H), (const bf16_t*)(ws + WS_WOUT), T_P, 1024, 1024}; pg8::StaticOrder S; S.init(T_P, 1024, G, c);
        EpiOut E{a.out, a.in[0], a.in[1], (const float*)(ws + WS_MOD)};
        pg8::gemm_phase<EpiOut, pg8::StaticOrder, true, true>(L, g, S, E);
        mini_gemm<2>((const bf16_t*)(ws + WS_H), (const bf16_t*)(ws + WS_WOUT), 1024, nullptr, nullptr, a.out, a.in[1], (const float*)(ws + WS_MOD));
    }
}

extern "C" void kernel_launch(void* const* d_in, const int* in_sizes, int n_in, void* d_out, int out_size, void* d_ws, size_t ws_size, hipStream_t stream) {
    static int grid = 0;
    if (grid == 0) {
        if (n_in != 24 || (size_t)out_size != O_END || ws_size < WS_END) { fprintf(stderr, "kernel_launch: unexpected shapes (n_in %d out %d ws %zu)\n", n_in, out_size, ws_size); grid = -1; return; }
        int dev = 0, cus = 0, per_cu = 0;
        hipGetDevice(&dev); hipDeviceGetAttribute(&cus, hipDeviceAttributeMultiprocessorCount, dev);
        if (hipFuncSetAttribute((const void*)fwd_megakernel, hipFuncAttributeMaxDynamicSharedMemorySize, LDS_BYTES) != hipSuccess) { fprintf(stderr, "kernel_launch: hipFuncSetAttribute failed\n"); grid = -1; return; }
        if (hipOccupancyMaxActiveBlocksPerMultiprocessor(&per_cu, (const void*)fwd_megakernel, 512, LDS_BYTES) != hipSuccess || per_cu < 1) per_cu = 1;
        (void)hipGetLastError();
        grid = cus * per_cu;
    }
    if (grid < 0) return;
    if (hipMemsetAsync((char*)d_ws + WS_BAR, 0, 16384, stream) != hipSuccess) { fprintf(stderr, "kernel_launch: memset failed\n"); return; }
    Args a{};
    for (int i = 0; i < 24; ++i) a.in[i] = (const float*)d_in[i];
    a.out = (float*)d_out; a.ws = (unsigned char*)d_ws;
    void* args[] = {&a};
    hipError_t e = hipLaunchCooperativeKernel((const void*)fwd_megakernel, dim3(grid), dim3(512), args, LDS_BYTES, stream);
    if (e != hipSuccess) fprintf(stderr, "cooperative launch failed: %s (grid %d)\n", hipGetErrorString(e), grid);
}
```
